# Optimizing an MI355X kernel written in HIP

```python
import jax, jax.numpy as jnp
from jax import lax
import numpy as np

D_MODEL = 2048
BATCH = 4
SEQ = 2048
DEPTH = 4

GRID_W = 64
CTX_LEN = 256
D_MIX = D_MODEL
W_CONV = D_MIX // 2
W_MLSTM = D_MIX - W_CONV
CONV_K = 31
CONV_PAD = CONV_K // 2
H_ML = 8
DH_ML = W_MLSTM // H_ML
CHUNK = 64
N_GATES = 4 * H_ML
N_IN = 3 * W_CONV + 5 * W_MLSTM + N_GATES
EPS = 1e-6
NEG = -1e30

kernel_name = "hymba_conformer_mlstm_prefix_dit"


def rmsnorm(x, g):
    x32 = x.astype(jnp.float32)
    r = x32 * lax.rsqrt(jnp.mean(x32 * x32, axis=-1, keepdims=True) + EPS)
    return (r * g.astype(jnp.float32)).astype(x.dtype)


def layernorm(x, g, b):
    x32 = x.astype(jnp.float32)
    mu = jnp.mean(x32, axis=-1, keepdims=True)
    xc = x32 - mu
    r = xc * lax.rsqrt(jnp.mean(xc * xc, axis=-1, keepdims=True) + EPS)
    return (r * g.astype(jnp.float32) + b.astype(jnp.float32)).astype(x.dtype)


def conv_latent(u, w, b):
    bsz, n, ch = u.shape
    rows = n // GRID_W
    grid = u.reshape(bsz, rows, GRID_W, ch)
    half = ch // 2
    dn = ('NHWC', 'HWIO', 'NHWC')
    yh = lax.conv_general_dilated(grid[..., :half], w[None, :, None, :half], (1, 1),
                                  [(0, 0), (CONV_PAD, CONV_PAD)], dimension_numbers=dn,
                                  feature_group_count=half)
    yv = lax.conv_general_dilated(grid[..., half:], w[:, None, None, half:], (1, 1),
                                  [(CONV_PAD, CONV_PAD), (0, 0)], dimension_numbers=dn,
                                  feature_group_count=ch - half)
    return jnp.concatenate([yh, yv], axis=-1).reshape(bsz, n, ch) + b


def conv_context(u, w, b):
    ch = u.shape[-1]
    y = lax.conv_general_dilated(u, w[:, None, :], (1,), [(CONV_PAD, CONV_PAD)],
                                 dimension_numbers=('NWC', 'WIO', 'NWC'),
                                 feature_group_count=ch)
    return y + b


def conformer_branch(a, g, z, conv_fn, w_dw, b_dw, ln_g, ln_b, w_pw2):
    u = a * jax.nn.sigmoid(g)
    u = conv_fn(u, w_dw, b_dw)
    u = layernorm(u, ln_g, ln_b)
    u = jax.nn.silu(u) @ w_pw2
    return u * jax.nn.silu(z)


def to_heads(p):
    bsz, n, _ = p.shape
    return p.reshape(bsz, n, H_ML, DH_ML).transpose(0, 2, 1, 3).astype(jnp.float32)


def mlstm_scan(q, k, v, log_i, log_f, state):
    bsz, nh, n, dh = q.shape
    nc = n // CHUNK

    def chunks(t):
        return jnp.moveaxis(t.reshape(t.shape[:2] + (nc, CHUNK) + t.shape[3:]), 2, 0)

    tril = jnp.tril(jnp.ones((CHUNK, CHUNK), dtype=bool))

    def step(carry, xs):
        c_st, n_st, m_st = carry
        qc, kc, vc, li, lf = xs
        b = jnp.cumsum(lf, axis=-1)
        dmat = b[..., :, None] - b[..., None, :] + li[..., None, :]
        dmat = jnp.where(tril, dmat, NEG)
        inter = b + m_st[..., None]
        m_t = jnp.maximum(inter, jnp.max(dmat, axis=-1))
        w_inter = jnp.exp(inter - m_t)
        pmat = jnp.exp(dmat - m_t[..., None]) * jnp.einsum('bhtd,bhsd->bhts', qc, kc)
        num = (w_inter[..., None] * jnp.einsum('bhtd,bhde->bhte', qc, c_st)
               + jnp.einsum('bhts,bhse->bhte', pmat, vc))
        den = w_inter * jnp.einsum('bhtd,bhd->bht', qc, n_st) + jnp.sum(pmat, axis=-1)
        h = num / jnp.maximum(jnp.abs(den), jnp.exp(-m_t))[..., None]
        b_last = b[..., -1]
        gl = b_last[..., None] - b + li
        m_new = jnp.maximum(b_last + m_st, jnp.max(gl, axis=-1))
        a = jnp.exp(b_last + m_st - m_new)
        ws = jnp.exp(gl - m_new[..., None])
        c_new = a[..., None, None] * c_st + jnp.einsum('bhsd,bhse->bhde', kc * ws[..., None], vc)
        n_new = a[..., None] * n_st + jnp.einsum('bhs,bhsd->bhd', ws, kc)
        return (c_new, n_new, m_new), h

    state, hs = lax.scan(step, state, (chunks(q), chunks(k), chunks(v), chunks(log_i), chunks(log_f)))
    h = jnp.moveaxis(hs, 0, 2).reshape(bsz, nh, n, dh)
    return h, state


def split_gates(gp, b_gate):
    g = (gp.astype(jnp.float32) + b_gate.astype(jnp.float32)).transpose(0, 2, 1)
    i_f, f_f, i_b, f_b = jnp.split(g, 4, axis=1)
    return i_f, jax.nn.log_sigmoid(f_f), i_b, jax.nn.log_sigmoid(f_b)


def mlstm_bidir(qx, kx, vx, gx, qc, kc, vc, gc, b_gate):
    scale = DH_ML ** -0.5
    qx, kx, vx = to_heads(qx) * scale, to_heads(kx), to_heads(vx)
    qc, kc, vc = to_heads(qc) * scale, to_heads(kc), to_heads(vc)
    ixf, fxf, ixb, fxb = split_gates(gx, b_gate)
    icf, fcf, icb, fcb = split_gates(gc, b_gate)
    bsz = qx.shape[0]
    init = (jnp.zeros((bsz, H_ML, DH_ML, DH_ML), jnp.float32),
            jnp.zeros((bsz, H_ML, DH_ML), jnp.float32),
            jnp.full((bsz, H_ML), NEG, jnp.float32))
    flip = lambda t: jnp.flip(t, axis=2)
    hcf, st_f = mlstm_scan(qc, kc, vc, icf, fcf, init)
    hxf, _ = mlstm_scan(qx, kx, vx, ixf, fxf, st_f)
    hcb, st_b = mlstm_scan(flip(qc), flip(kc), flip(vc), flip(icb), flip(fcb), init)
    hxb, _ = mlstm_scan(flip(qx), flip(kx), flip(vx), flip(ixb), flip(fxb), st_b)
    return hxf + flip(hxb), hcf + flip(hcb)


def mlstm_out(h, o, z, g_head, dtype):
    mu = jnp.mean(h, axis=-1, keepdims=True)
    hc = h - mu
    hn = hc * lax.rsqrt(jnp.mean(hc * hc, axis=-1, keepdims=True) + EPS)
    bsz, _, n, _ = h.shape
    hn = hn.transpose(0, 2, 1, 3).reshape(bsz, n, W_MLSTM) * g_head.astype(jnp.float32)
    return (hn * jax.nn.sigmoid(o.astype(jnp.float32))).astype(dtype) * jax.nn.silu(z)


def split_proj(p):
    cuts = np.cumsum([W_CONV, W_CONV, W_CONV, W_MLSTM, W_MLSTM, W_MLSTM, W_MLSTM, W_MLSTM])
    return jnp.split(p, [int(t) for t in cuts], axis=-1)


def setup_inputs(seed: int = 0) -> dict:
    key = jax.random.key(seed)
    ks = jax.random.split(key, 17)
    nrm = jax.random.normal
    f32 = jnp.float32
    gate_base = jnp.concatenate([jnp.zeros((H_ML,), f32), jnp.full((H_ML,), 3.0, f32),
                                 jnp.zeros((H_ML,), f32), jnp.full((H_ML,), 3.0, f32)])
    return {
        "x": nrm(ks[0], (BATCH, SEQ, D_MODEL), f32),
        "c": nrm(ks[1], (BATCH, D_MODEL), f32),
        "ctx": nrm(ks[2], (BATCH, CTX_LEN, D_MODEL), f32),
        "c_ctx": nrm(ks[3], (D_MODEL,), f32),
        "w_ada": nrm(ks[4], (DEPTH, D_MODEL, 3 * D_MODEL), f32) * (0.5 * D_MODEL ** -0.5),
        "b_ada": nrm(ks[5], (DEPTH, 3 * D_MODEL), f32) * 0.01,
        "g_pre": 1.0 + 0.1 * nrm(ks[6], (DEPTH, D_MODEL), f32),
        "g_post": 1.0 + 0.1 * nrm(ks[7], (DEPTH, D_MODEL), f32),
        "w_in": nrm(ks[8], (DEPTH, D_MODEL, N_IN), f32) * D_MODEL ** -0.5,
        "b_gate": gate_base + 0.3 * nrm(ks[9], (DEPTH, N_GATES), f32),
        "w_dw": nrm(ks[10], (DEPTH, CONV_K, W_CONV), f32) * CONV_K ** -0.5,
        "b_dw": nrm(ks[11], (DEPTH, W_CONV), f32) * 0.01,
        "ln_g": 1.0 + 0.1 * nrm(ks[12], (DEPTH, W_CONV), f32),
        "ln_b": nrm(ks[13], (DEPTH, W_CONV), f32) * 0.01,
        "w_pw2": nrm(ks[14], (DEPTH, W_CONV, W_CONV), f32) * W_CONV ** -0.5,
        "g_head": 1.0 + 0.1 * nrm(ks[15], (DEPTH, W_MLSTM), f32),
        "w_out": nrm(ks[16], (DEPTH, D_MIX, D_MODEL), f32) * D_MIX ** -0.5,
    }


def reference(x, c, ctx, c_ctx, w_ada, b_ada, g_pre, g_post, w_in, b_gate, w_dw, b_dw,
              ln_g, ln_b, w_pw2, g_head, w_out):
    for l in range(DEPTH):
        last = l == DEPTH - 1
        ada_x = jax.nn.silu(c) @ w_ada[l] + b_ada[l]
        ada_c = jax.nn.silu(c_ctx) @ w_ada[l] + b_ada[l]
        sh_x, sc_x, gt_x = jnp.split(ada_x[:, None, :], 3, axis=-1)
        sh_c, sc_c, gt_c = jnp.split(ada_c, 3, axis=-1)
        hx = rmsnorm(x, g_pre[l]) * (1.0 + sc_x) + sh_x
        hc = rmsnorm(ctx, g_pre[l]) * (1.0 + sc_c) + sh_c
        ax, gx_, zx, qx, kx, vx, ox, zmx, gatex = split_proj(hx @ w_in[l])
        ac, gc_, zc, qc, kc, vc, oc, zmc, gatec = split_proj(hc @ w_in[l])
        h_x, h_c = mlstm_bidir(qx, kx, vx, gatex, qc, kc, vc, gatec, b_gate[l])
        ym_x = mlstm_out(h_x, ox, zmx, g_head[l], x.dtype)
        yc_x = conformer_branch(ax, gx_, zx, conv_latent, w_dw[l], b_dw[l], ln_g[l], ln_b[l], w_pw2[l])
        out_x = jnp.concatenate([yc_x, ym_x], axis=-1) @ w_out[l]
        x_new = x + gt_x * rmsnorm(out_x, g_post[l])
        if not last:
            ym_c = mlstm_out(h_c, oc, zmc, g_head[l], ctx.dtype)
            yc_c = conformer_branch(ac, gc_, zc, conv_context, w_dw[l], b_dw[l], ln_g[l], ln_b[l], w_pw2[l])
            out_c = jnp.concatenate([yc_c, ym_c], axis=-1) @ w_out[l]
            ctx = ctx + gt_c * rmsnorm(out_c, g_post[l])
        x = x_new
    return x
```

```cpp
#include <hip/hip_runtime.h>
#include <hip/hip_cooperative_groups.h>
#include <cstdio>
namespace cg = cooperative_groups;

#define LAS __attribute__((address_space(3)))
typedef unsigned short bf16_t;
typedef short bf16x8 __attribute__((ext_vector_type(8)));
typedef float f32x4 __attribute__((ext_vector_type(4)));
typedef unsigned u32x4 __attribute__((ext_vector_type(4)));
typedef unsigned u32x2 __attribute__((ext_vector_type(2)));

constexpr int DM = 2048, SEQL = 2048, DEPTH = 4, CTXL = 256;
constexpr int MLAT = 8192, MTOT = 9216, WCV = 1024, NIN = 8224, NINP = 8448;
constexpr float EPS = 1e-6f, NEGV = -1e30f;
constexpr int LDS_BYTES = 163840;
#ifndef PROBE_PH
#define PROBE_PH -1
#define PROBE_REPS 0
#endif

constexpr size_t SZ_WIN = (size_t)DEPTH * NINP * DM * 2, SZ_WOUT = (size_t)DEPTH * DM * DM * 2, SZ_WPW = (size_t)DEPTH * WCV * WCV * 2;
constexpr size_t SZ_ADA = (size_t)DEPTH * 5 * 6144 * 4, SZ_T2K = (size_t)MTOT * 2048 * 2, SZ_T1K = (size_t)MTOT * 1024 * 2;
constexpr size_t SZ_G = (size_t)MTOT * 32 * 4, SZ_H = (size_t)MTOT * 1024 * 4, SZ_F2K = (size_t)MTOT * 2048 * 4;
constexpr size_t OFF_WIN = 0, OFF_WOUT = OFF_WIN + SZ_WIN, OFF_WPW = OFF_WOUT + SZ_WOUT, OFF_ADA = OFF_WPW + SZ_WPW;
constexpr size_t OFF_HX = OFF_ADA + SZ_ADA, OFF_U = OFF_HX + SZ_T2K, OFF_Z = OFF_U + SZ_T1K, OFF_Q = OFF_Z + SZ_T1K, OFF_K = OFF_Q + SZ_T1K;
constexpr size_t OFF_V = OFF_K + SZ_T1K, OFF_OG = OFF_V + SZ_T1K, OFF_UC = OFF_OG + SZ_T1K, OFF_G = OFF_UC + SZ_T1K;
constexpr size_t OFF_HF = OFF_G + SZ_G, OFF_HB = OFF_HF + SZ_H, OFF_CAT = OFF_HB + SZ_H, OFF_OUT = OFF_CAT + SZ_T2K, OFF_XW = OFF_OUT + SZ_F2K;
constexpr size_t OFF_BAR = OFF_XW + SZ_F2K;
constexpr size_t WS_END = OFF_BAR + 16384;

struct Params {
    const float *x, *c, *ctx, *c_ctx, *w_ada, *b_ada, *g_pre, *g_post, *w_in, *b_gate, *w_dw, *b_dw, *ln_g, *ln_b, *w_pw2, *g_head, *w_out;
    float* out; unsigned char* ws;
    int ph_lo, ph_hi;
};

__device__ __forceinline__ unsigned cvt_pk_bf16(float lo, float hi) { unsigned r; asm("v_cvt_pk_bf16_f32 %0, %1, %2" : "=v"(r) : "v"(lo), "v"(hi)); return r; }
__device__ __forceinline__ f32x4 zero4() { float z = 0.f; asm volatile("" : "+v"(z)); return (f32x4){z, z, z, z}; }
__device__ __forceinline__ float bflo(unsigned w) { return __uint_as_float(w << 16); }
__device__ __forceinline__ float bfhi(unsigned w) { return __uint_as_float(w & 0xffff0000u); }
__device__ __forceinline__ float sigmoidf_(float x) { return __builtin_amdgcn_rcpf(1.0f + __expf(-x)); }
__device__ __forceinline__ float siluf_(float x) { return x * sigmoidf_(x); }
__device__ __forceinline__ float bperm(float v, int srclane) { return __int_as_float(__builtin_amdgcn_ds_bpermute(srclane << 2, __float_as_int(v))); }
__device__ __forceinline__ float wave_sum(float v, int lane) {
#pragma unroll
    for (int o = 32; o >= 1; o >>= 1) v += bperm(v, lane ^ o);
    return v;
}
__host__ __device__ __forceinline__ int perm32(int rho) { const int n = rho >> 4, i = rho & 15; return 8 * (i >> 2) + 4 * n + (i & 3); }
__device__ __forceinline__ int colmap_in(int np) {
    const int pn = np >> 8, within = np & 255, bj = within >> 7, w32 = (within >> 5) & 3, rho = within & 31;
    const int lc = w32 * 32 + perm32(rho);
    if (pn < 8) return (bj ? 1024 : 0) + pn * 128 + lc;
    if (pn < 24) return 2048 + (pn - 8) * 256 + bj * 128 + lc;
    if (pn < 32) return (bj ? 7168 : 6144) + (pn - 24) * 128 + lc;
    return within < 32 ? 8192 + within : -1;
}


#define XB_TMO      128
#define XB_XCNT(j)  (256  + 64 * (j))
#define XB_XSUB(j)  (1280 + 64 * (j))
#define XB_XGEN(j)  (2304 + 64 * (j))
#define XB_TOP      3328
#define XB_TOPGEN   3392
#define XCD_BAR_WORDS 3456
#define XB_SPIN_CAP (1u << 18)
__device__ __forceinline__ unsigned xb_ld(unsigned* p)              { return __hip_atomic_load(p, __ATOMIC_RELAXED, __HIP_MEMORY_SCOPE_AGENT); }
__device__ __forceinline__ unsigned xb_add(unsigned* p, unsigned v) { return __hip_atomic_fetch_add(p, v, __ATOMIC_RELAXED, __HIP_MEMORY_SCOPE_AGENT); }
__device__ __forceinline__ unsigned xb_xcc_id() { return (unsigned)__builtin_amdgcn_s_getreg((3 << 11) | 20) & 0xFu; }
#define XB_SPIN(cond, bar) do { unsigned _sp = 0; while (cond) { __builtin_amdgcn_s_sleep(1); \
    if ((++_sp & 255u) == 0u) { if (xb_ld(&(bar)[XB_TMO])) break; if (_sp > XB_SPIN_CAP) { atomicAdd(&(bar)[XB_TMO], 1u); break; } } } } while (0)
struct XcdBarrier { unsigned* bar; unsigned x; volatile LAS unsigned* st; };
__device__ __forceinline__ XcdBarrier xcd_barrier_post(unsigned* bar, volatile LAS unsigned* st) {
    XcdBarrier b; b.bar = bar; b.x = xb_xcc_id(); b.st = st;
    if (threadIdx.x == 0) (void)xb_add(&bar[XB_XCNT(b.x)], 1u);
    return b;
}
__device__ __forceinline__ void xcd_barrier_complete(unsigned* bar, unsigned x, unsigned& nloc, unsigned& nx) {
    const unsigned G = gridDim.x * gridDim.y * gridDim.z;
    unsigned sum, cnt, mine, sp = 0u;
    for (;;) {
        sum = 0u; cnt = 0u; mine = 0u;
#pragma unroll
        for (unsigned j = 0; j < 16; ++j) { const unsigned c = xb_ld(&bar[XB_XCNT(j)]); sum += c; cnt += (c > 0u) ? 1u : 0u; mine = (j == x) ? c : mine; }
        if (sum == G) break;
        __builtin_amdgcn_s_sleep(1);
        if ((++sp & 255u) == 0u) { if (xb_ld(&bar[XB_TMO])) break; if (sp > XB_SPIN_CAP) { atomicAdd(&bar[XB_TMO], 1u); break; } }
    }
    nloc = mine > 0u ? mine : 1u; nx = cnt > 0u ? cnt : 1u;
}
__device__ __forceinline__ void xcd_barrier(const XcdBarrier& b) {
    asm volatile("s_waitcnt vmcnt(0)" ::: "memory");
    __syncthreads();
    if (threadIdx.x == 0) {
        unsigned* bar = b.bar;
        __builtin_amdgcn_s_waitcnt(0);
        unsigned nloc = b.st[0], nx = b.st[1];
        if (nloc == 0u) { xcd_barrier_complete(bar, b.x, nloc, nx); b.st[0] = nloc; b.st[1] = nx; }
        const unsigned old = xb_add(&bar[XB_XSUB(b.x)], 1u);
        const unsigned gen = old / nloc;
        if (old + 1u == (gen + 1u) * nloc) {
            __builtin_amdgcn_fence(__ATOMIC_RELEASE, "agent");
            asm volatile("s_waitcnt vmcnt(0)" ::: "memory");
            const unsigned og = xb_add(&bar[XB_TOP], 1u);
            const unsigned tg = og / nx;
            if (og + 1u == (tg + 1u) * nx) xb_add(&bar[XB_TOPGEN], 1u);
            else XB_SPIN(xb_ld(&bar[XB_TOPGEN]) == tg, bar);
            __builtin_amdgcn_fence(__ATOMIC_ACQUIRE, "agent");
            xb_add(&bar[XB_XGEN(b.x)], 1u);
            asm volatile("s_waitcnt vmcnt(0)" ::: "memory");
        } else {
            XB_SPIN(xb_ld(&bar[XB_XGEN(b.x)]) == gen, bar);
            __builtin_amdgcn_fence(__ATOMIC_ACQUIRE, "agent");
            asm volatile("s_waitcnt vmcnt(0)" ::: "memory");
        }
    }
    __syncthreads();
}

constexpr int BM = 256, BK = 64, HALF = 128, HTB = HALF * BK * 2, NXCD = 8, WGM = 8;
__host__ __device__ __forceinline__ int lds_byte(int r, int c) { const int st = (r >> 4) * 2 + (c >> 5), rr = r & 15, cc = c & 31, ob = rr * 64 + cc * 2; return st * 1024 + (ob ^ (((ob >> 9) & 1) << 5)); }
__host__ __device__ __forceinline__ void stage_rc(int b, int& R, int& C) { const int st = b / 1024, sb = b % 1024, swz = sb ^ (((sb >> 9) & 1) << 5); R = (st >> 1) * 16 + swz / 64; C = (st & 1) * 32 + (swz % 64) / 2; }
struct Unit { int pm, pn; };
struct StaticOrder {
    int nM, nN, nwg, G, c;
    __device__ void init(int M, int N, int G_, int c_) { nM = M / BM; nN = N / BM; nwg = nM * nN; G = G_; c = c_; }
    __device__ bool next(int i, Unit& u) const {
        const long L = (long)i * G + c; if (L >= nwg) return false;
        int wgid = (int)L; { const int q = nwg / NXCD, r = nwg % NXCD, xcd = wgid % NXCD, off = wgid / NXCD; wgid = (xcd < r ? xcd * (q + 1) : r * (q + 1) + (xcd - r) * q) + off; }
        const int nig = WGM * nN, gid = wgid / nig, fm = gid * WGM, gsz = (nM - fm) < WGM ? (nM - fm) : WGM;
        u.pm = fm + ((wgid % nig) % gsz); u.pn = (wgid % nig) / gsz; return true;
    }
};

template <class Epi>
__device__ __forceinline__ void gemm_phase(LAS unsigned char* lds, const bf16_t* gA, const bf16_t* gBt, int M, int N, int K, const Epi E) {
    int tid_ = threadIdx.x; asm volatile("" : "+v"(tid_));
    const int tid = tid_, wid = __builtin_amdgcn_readfirstlane(tid >> 6), lane = tid & 63, wr = wid >> 2, wc = wid & 3, fr = lane & 15, fq = lane >> 4;
    const int nt = K / BK;
    StaticOrder S; S.init(M, N, (int)gridDim.x, (int)blockIdx.x);
    unsigned voffA[2];
#pragma unroll
    for (int i = 0; i < 2; ++i) { int R, C; stage_rc(tid * 16 + i * 8192, R, C); voffA[i] = (unsigned)(R * K + C) * 2u; }
    const size_t kstep = (size_t)(BK * 2);
    const size_t hstep = (size_t)HALF * K * 2;
    const size_t tstep = 2 * hstep;
    const unsigned ldsw = (unsigned)wid * 1024u;
    const int aoff = lds_byte(wr * 64 + fr, fq * 8), boff = lds_byte(wc * 32 + fr, fq * 8);
#define PG8_SA(b, h) (((b) * 2 + (h)) * HTB)
#define PG8_SB(b, h) ((4 + (b) * 2 + (h)) * HTB)
#define PG8_STAGE(bufoff, gbase, voff) do { _Pragma("unroll") for (int _i = 0; _i < 2; ++_i) \
        __builtin_amdgcn_global_load_lds((const unsigned*)((const char*)(gbase) + (voff)[_i]), (LAS unsigned*)(lds + (bufoff) + ldsw + _i * 8192), 16, 0, 0); } while (0)
#define PG8_LDA(dst, b, h) do { _Pragma("unroll") for (int m = 0; m < 4; ++m) _Pragma("unroll") for (int k = 0; k < 2; ++k) dst[m][k] = *(const LAS bf16x8*)(lds + PG8_SA(b, h) + aoff + m * 2048 + k * 1024); } while (0)
#define PG8_LDB(dst, b, h) do { _Pragma("unroll") for (int n = 0; n < 2; ++n) _Pragma("unroll") for (int k = 0; k < 2; ++k) dst[n][k] = *(const LAS bf16x8*)(lds + PG8_SB(b, h) + boff + n * 2048 + k * 1024); } while (0)
#define PG8_MMA(ai, bj, At, Bt) do { __builtin_amdgcn_s_setprio(1); _Pragma("unroll") for (int m = 0; m < 4; ++m) _Pragma("unroll") for (int n = 0; n < 2; ++n) _Pragma("unroll") for (int k = 0; k < 2; ++k) \
        acc[ai][bj][m][n] = __builtin_amdgcn_mfma_f32_16x16x32_bf16(Bt[n][k], At[m][k], acc[ai][bj][m][n], 0, 0, 0); __builtin_amdgcn_s_setprio(0); } while (0)
#define PG8_WAIT_V(n) asm volatile("s_waitcnt vmcnt(" #n ")" ::: "memory")
#define PG8_WAIT_L(n) asm volatile("s_waitcnt lgkmcnt(" #n ")" ::: "memory")
#define PG8_BAR __builtin_amdgcn_s_barrier()
#define PG8_SCHED __builtin_amdgcn_sched_barrier(0)
    Unit cur, nxt; int ui = 0;
    if (!S.next(0, cur)) return;
    f32x4 acc[2][2][4][2];
#pragma unroll
    for (int a = 0; a < 2; ++a)
#pragma unroll
        for (int b = 0; b < 2; ++b)
#pragma unroll
            for (int m = 0; m < 4; ++m)
#pragma unroll
                for (int n = 0; n < 2; ++n) acc[a][b][m][n] = zero4();
    bf16x8 At[4][2], B0[2][2], B1[2][2];
    const char* cA = (const char*)gA + (size_t)cur.pm * tstep; const char* cB = (const char*)gBt + (size_t)cur.pn * tstep;
    PG8_STAGE(PG8_SB(0, 0), cB, voffA); PG8_STAGE(PG8_SA(0, 0), cA, voffA); PG8_STAGE(PG8_SB(0, 1), cB + hstep, voffA); PG8_STAGE(PG8_SA(0, 1), cA + hstep, voffA);
    if (wr == 1) PG8_BAR;
    PG8_WAIT_V(4); PG8_BAR;
    PG8_STAGE(PG8_SB(1, 0), cB + kstep, voffA); PG8_STAGE(PG8_SA(1, 0), cA + kstep, voffA); PG8_STAGE(PG8_SB(1, 1), cB + hstep + kstep, voffA);
    PG8_WAIT_V(6); PG8_BAR;
    for (;;) {
        const bool has_next = S.next(ui + 1, nxt);
        const char* nA = has_next ? (const char*)gA + (size_t)nxt.pm * tstep : cA; const char* nB = has_next ? (const char*)gBt + (size_t)nxt.pn * tstep : cB;
        for (int t = 0; t < nt; t += 2) {
            const bool last = (t == nt - 2);
            const char* a1 = cA + (size_t)(t + 1) * kstep;
            const char* a2 = last ? nA : cA + (size_t)(t + 2) * kstep; const char* b2 = last ? nB : cB + (size_t)(t + 2) * kstep;
            const char* a3 = a2 + kstep; const char* b3 = b2 + kstep;
            PG8_LDB(B0, 0, 0); PG8_SCHED; PG8_LDA(At, 0, 0); PG8_STAGE(PG8_SA(1, 1), a1 + hstep, voffA);
            PG8_WAIT_L(8); PG8_BAR; PG8_WAIT_L(0); PG8_MMA(0, 0, At, B0); PG8_BAR; PG8_SCHED;
            PG8_LDB(B1, 0, 1); PG8_STAGE(PG8_SB(0, 0), b2, voffA);
            PG8_BAR; PG8_WAIT_L(0); PG8_MMA(0, 1, At, B1); PG8_BAR;
            PG8_LDA(At, 0, 1); PG8_STAGE(PG8_SA(0, 0), a2, voffA);
            PG8_BAR; PG8_WAIT_L(0); PG8_MMA(1, 0, At, B0); PG8_BAR; PG8_SCHED;
            PG8_STAGE(PG8_SB(0, 1), b2 + hstep, voffA);
            PG8_WAIT_V(6); PG8_BAR; PG8_MMA(1, 1, At, B1); PG8_BAR;
            PG8_LDB(B0, 1, 0); PG8_SCHED; PG8_LDA(At, 1, 0); PG8_STAGE(PG8_SA(0, 1), a2 + hstep, voffA);
            PG8_WAIT_L(8); PG8_BAR; PG8_WAIT_L(0); PG8_MMA(0, 0, At, B0); PG8_BAR; PG8_SCHED;
            PG8_LDB(B1, 1, 1); PG8_STAGE(PG8_SB(1, 0), b3, voffA);
            PG8_BAR; PG8_WAIT_L(0); PG8_MMA(0, 1, At, B1); PG8_BAR;
            PG8_LDA(At, 1, 1); PG8_STAGE(PG8_SA(1, 0), a3, voffA);
            PG8_BAR; PG8_WAIT_L(0); PG8_MMA(1, 0, At, B0); PG8_BAR; PG8_SCHED;
            PG8_STAGE(PG8_SB(1, 1), b3 + hstep, voffA);
            PG8_WAIT_V(6); PG8_BAR; PG8_MMA(1, 1, At, B1); PG8_BAR;
        }
        E(acc, cur, wr, wc, fr, fq);
        if (!has_next) break;
#pragma unroll
        for (int a = 0; a < 2; ++a)
#pragma unroll
            for (int b = 0; b < 2; ++b)
#pragma unroll
                for (int m = 0; m < 4; ++m)
#pragma unroll
                    for (int n = 0; n < 2; ++n) acc[a][b][m][n] = zero4();
        cur = nxt; cA = nA; cB = nB; ++ui;
    }
    PG8_WAIT_V(0);
    if (wr == 0) PG8_BAR;
    PG8_BAR;
#undef PG8_SA
#undef PG8_SB
#undef PG8_STAGE
#undef PG8_LDA
#undef PG8_LDB
#undef PG8_MMA
#undef PG8_WAIT_V
#undef PG8_WAIT_L
#undef PG8_BAR
#undef PG8_SCHED
}

struct EpiIn {
    unsigned char* ws;
    __device__ __forceinline__ void operator()(const f32x4 (&acc)[2][2][4][2], const Unit& u, int wr, int wc, int fr, int fq) const {
        bf16_t* const U = (bf16_t*)(ws + OFF_U); bf16_t* const Z = (bf16_t*)(ws + OFF_Z); bf16_t* const Q = (bf16_t*)(ws + OFF_Q); bf16_t* const Kp = (bf16_t*)(ws + OFF_K);
        bf16_t* const V = (bf16_t*)(ws + OFF_V); bf16_t* const OG = (bf16_t*)(ws + OFF_OG); float* const G = (float*)(ws + OFF_G);
        const int row0 = u.pm * BM + wr * 64 + fr, pn = u.pn, lc0 = wc * 32 + 8 * fq;
        if (pn < 8 || (pn >= 24 && pn < 32)) {
            const bool glu = pn < 8;
            bf16_t* dst = glu ? U : OG; const int colb = (glu ? pn : pn - 24) * 128 + lc0;
#pragma unroll
            for (int ai = 0; ai < 2; ++ai)
#pragma unroll
                for (int m = 0; m < 4; ++m) {
                    const size_t r = (size_t)(row0 + ai * HALF + m * 16);
                    float o[8];
#pragma unroll
                    for (int n = 0; n < 2; ++n)
#pragma unroll
                        for (int j = 0; j < 4; ++j) {
                            const float a = acc[ai][0][m][n][j], g = acc[ai][1][m][n][j];
                            o[n * 4 + j] = glu ? a * sigmoidf_(g) : sigmoidf_(a) * siluf_(g);
                        }
                    u32x4 w; w.x = cvt_pk_bf16(o[0], o[1]); w.y = cvt_pk_bf16(o[2], o[3]); w.z = cvt_pk_bf16(o[4], o[5]); w.w = cvt_pk_bf16(o[6], o[7]);
                    *(u32x4*)(dst + r * 1024 + colb) = w;
                }
        } else if (pn < 24) {
            const int t = (pn - 8) >> 2;
            bf16_t* dst = t == 0 ? Z : (t == 1 ? Q : (t == 2 ? Kp : V));
            const int colb = ((pn - 8) & 3) * 256 + lc0;
            const float qs = 0.08838834764831845f;
#pragma unroll
            for (int ai = 0; ai < 2; ++ai)
#pragma unroll
                for (int m = 0; m < 4; ++m) {
                    const size_t r = (size_t)(row0 + ai * HALF + m * 16);
#pragma unroll
                    for (int bj = 0; bj < 2; ++bj) {
                        float o[8];
#pragma unroll
                        for (int n = 0; n < 2; ++n)
#pragma unroll
                            for (int j = 0; j < 4; ++j) {
                                const float a = acc[ai][bj][m][n][j];
                                o[n * 4 + j] = t == 0 ? siluf_(a) : (t == 1 ? a * qs : a);
                            }
                        u32x4 w; w.x = cvt_pk_bf16(o[0], o[1]); w.y = cvt_pk_bf16(o[2], o[3]); w.z = cvt_pk_bf16(o[4], o[5]); w.w = cvt_pk_bf16(o[6], o[7]);
                        *(u32x4*)(dst + r * 1024 + colb + bj * HALF) = w;
                    }
                }
        } else {
            if (wc == 0) {
#pragma unroll
                for (int ai = 0; ai < 2; ++ai)
#pragma unroll
                    for (int m = 0; m < 4; ++m) {
                        const size_t r = (size_t)(row0 + ai * HALF + m * 16);
#pragma unroll
                        for (int n = 0; n < 2; ++n)
#pragma unroll
                            for (int j = 0; j < 4; ++j) G[(size_t)(16 * n + 4 * fq + j) * MTOT + r] = acc[ai][0][m][n][j];
                    }
            }
        }
    }
};
struct EpiPw {
    unsigned char* ws;
    __device__ __forceinline__ void operator()(const f32x4 (&acc)[2][2][4][2], const Unit& u, int wr, int wc, int fr, int fq) const {
        const bf16_t* __restrict__ const Z = (const bf16_t*)(ws + OFF_Z); bf16_t* __restrict__ const CAT = (bf16_t*)(ws + OFF_CAT);
        const int row0 = u.pm * BM + wr * 64 + fr, colb = u.pn * BM + wc * 32 + 8 * fq;
#pragma unroll
        for (int ai = 0; ai < 2; ++ai) {
            u32x4 zz[4][2];
#pragma unroll
            for (int m = 0; m < 4; ++m)
#pragma unroll
                for (int bj = 0; bj < 2; ++bj) zz[m][bj] = *(const u32x4*)(Z + (size_t)(row0 + ai * HALF + m * 16) * 1024 + colb + bj * HALF);
#pragma unroll
            for (int m = 0; m < 4; ++m) {
                const size_t r = (size_t)(row0 + ai * HALF + m * 16);
#pragma unroll
                for (int bj = 0; bj < 2; ++bj) {
                    const u32x4 z = zz[m][bj];
                    const f32x4 v0 = acc[ai][bj][m][0], v1 = acc[ai][bj][m][1];
                    u32x4 w;
                    w.x = cvt_pk_bf16(v0[0] * bflo(z.x), v0[1] * bfhi(z.x)); w.y = cvt_pk_bf16(v0[2] * bflo(z.y), v0[3] * bfhi(z.y));
                    w.z = cvt_pk_bf16(v1[0] * bflo(z.z), v1[1] * bfhi(z.z)); w.w = cvt_pk_bf16(v1[2] * bflo(z.w), v1[3] * bfhi(z.w));
                    *(u32x4*)(CAT + r * 2048 + colb + bj * HALF) = w;
                }
            }
        }
    }
};
struct EpiOut {
    unsigned char* ws;
    __device__ __forceinline__ void operator()(const f32x4 (&acc)[2][2][4][2], const Unit& u, int wr, int wc, int fr, int fq) const {
        bf16_t* const O = (bf16_t*)(ws + OFF_OUT);
        const int row0 = u.pm * BM + wr * 64 + fr, colb = u.pn * BM + wc * 32 + 8 * fq;
#pragma unroll
        for (int ai = 0; ai < 2; ++ai)
#pragma unroll
            for (int m = 0; m < 4; ++m) {
                const size_t r = (size_t)(row0 + ai * HALF + m * 16);
#pragma unroll
                for (int bj = 0; bj < 2; ++bj) {
                    const f32x4 v0 = acc[ai][bj][m][0], v1 = acc[ai][bj][m][1];
                    u32x4 w; w.x = cvt_pk_bf16(v0[0], v0[1]); w.y = cvt_pk_bf16(v0[2], v0[3]); w.z = cvt_pk_bf16(v1[0], v1[1]); w.w = cvt_pk_bf16(v1[2], v1[3]);
                    *(u32x4*)(O + r * 2048 + colb + bj * HALF) = w;
                }
            }
    }
};

__device__ __forceinline__ void side_work(const Params& p, LAS unsigned char* lds, int tasks, int l_ada, int l_w, int sid, int nside) {
    int tid_ = threadIdx.x; asm volatile("" : "+v"(tid_));
    const int tid = tid_, wid = tid >> 6, lane = tid & 63;
    LAS float* s5 = (LAS float*)lds;
    LAS float* red = (LAS float*)(lds + 40960);
    __syncthreads();
    if (tasks & 1) {
        for (int i = tid; i < 5 * 2048; i += 512) { const int r = i >> 11, k = i & 2047; const float v = r < 4 ? p.c[r * 2048 + k] : p.c_ctx[k]; s5[i] = siluf_(v); }
        __syncthreads();
        float* ADA = (float*)(p.ws + OFF_ADA);
        const int l = l_ada;
        for (int item = sid; item < 192; item += nside) {
            const int cq = lane & 7, kq = lane >> 3, col0 = item * 32;
            const float* w = p.w_ada + (size_t)l * 2048 * 6144 + col0 + cq * 4;
            f32x4 a0 = zero4(), a1 = a0, a2 = a0, a3 = a0, a4 = a0;
            const int k0 = wid * 256 + kq;
#pragma unroll 1
            for (int ib = 0; ib < 32; ib += 8) {
                f32x4 wv[8];
#pragma unroll
                for (int i = 0; i < 8; ++i) wv[i] = __builtin_nontemporal_load((const f32x4*)(w + (size_t)(k0 + 8 * (ib + i)) * 6144));
#pragma unroll
                for (int i = 0; i < 8; ++i) { const int k = k0 + 8 * (ib + i);
                    a0 += wv[i] * s5[k]; a1 += wv[i] * s5[2048 + k]; a2 += wv[i] * s5[4096 + k]; a3 += wv[i] * s5[6144 + k]; a4 += wv[i] * s5[8192 + k]; }
            }
#pragma unroll
            for (int j = 0; j < 4; ++j) {
#pragma unroll
                for (int o = 8; o < 64; o <<= 1) { a0[j] += bperm(a0[j], lane ^ o); a1[j] += bperm(a1[j], lane ^ o); a2[j] += bperm(a2[j], lane ^ o); a3[j] += bperm(a3[j], lane ^ o); a4[j] += bperm(a4[j], lane ^ o); }
            }
            if (lane < 8) {
                *(LAS f32x4*)(red + (wid * 5 + 0) * 32 + cq * 4) = a0; *(LAS f32x4*)(red + (wid * 5 + 1) * 32 + cq * 4) = a1; *(LAS f32x4*)(red + (wid * 5 + 2) * 32 + cq * 4) = a2;
                *(LAS f32x4*)(red + (wid * 5 + 3) * 32 + cq * 4) = a3; *(LAS f32x4*)(red + (wid * 5 + 4) * 32 + cq * 4) = a4;
            }
            __syncthreads();
            if (tid < 160) {
                const int r = tid >> 5, cl = tid & 31, cc = col0 + cl; float s = p.b_ada[l * 6144 + cc];
#pragma unroll
                for (int w8 = 0; w8 < 8; ++w8) s += red[(w8 * 5 + r) * 32 + cl];
                ADA[(size_t)(l * 5 + r) * 6144 + cc] = s;
            }
            __syncthreads();
        }
    }
    constexpr int NT_IN = (NINP / 64) * 32, NT_OUT = 32 * 32, NT_PW = 16 * 16;
    if (tasks & 6) {
        const int t_lo = (tasks & 2) ? 0 : NT_IN, t_hi = (tasks & 4) ? NT_IN + NT_OUT + NT_PW : NT_IN;
        const int l = l_w;
        for (int t = t_lo + sid * 8 + wid; t < t_hi; t += nside * 8) {
            const float* src; bf16_t* dst; int NS, K, nb, kb, kind;
            if (t < NT_IN) { kb = t / 132; nb = t % 132; src = p.w_in + (size_t)l * 2048 * NIN; NS = NIN; K = 2048; dst = (bf16_t*)(p.ws + OFF_WIN) + (size_t)l * NINP * 2048; kind = 0; }
            else if (t < NT_IN + NT_OUT) { const int t2 = t - NT_IN; kb = t2 / 32; nb = t2 % 32; src = p.w_out + (size_t)l * 2048 * 2048; NS = 2048; K = 2048; dst = (bf16_t*)(p.ws + OFF_WOUT) + (size_t)l * 2048 * 2048; kind = 1; }
            else { const int t3 = t - NT_IN - NT_OUT; kb = t3 / 16; nb = t3 % 16; src = p.w_pw2 + (size_t)l * 1024 * 1024; NS = 1024; K = 1024; dst = (bf16_t*)(p.ws + OFF_WPW) + (size_t)l * 1024 * 1024; kind = 2; }
            const int np = nb * 64 + lane;
            const int col = kind == 0 ? colmap_in(np) : (np & ~31) + perm32(np & 31);
            const float* sp = src + (size_t)(kb * 64) * NS + (col >= 0 ? col : 0);
            float v[64];
#pragma unroll
            for (int i = 0; i < 64; ++i) v[i] = __builtin_nontemporal_load(sp + (size_t)i * NS);
            if (col < 0) {
#pragma unroll
                for (int i = 0; i < 64; ++i) v[i] = 0.f;
            }
            LAS unsigned char* tw = lds + 51200 + wid * 9216;
#pragma unroll
            for (int j = 0; j < 8; ++j) {
                u32x4 w; w.x = cvt_pk_bf16(v[8 * j], v[8 * j + 1]); w.y = cvt_pk_bf16(v[8 * j + 2], v[8 * j + 3]); w.z = cvt_pk_bf16(v[8 * j + 4], v[8 * j + 5]); w.w = cvt_pk_bf16(v[8 * j + 6], v[8 * j + 7]);
                *(LAS u32x4*)(tw + lane * 144 + j * 16) = w;
            }
            bf16_t* dp = dst + (size_t)(nb * 64) * K + kb * 64;
#pragma unroll
            for (int s = 0; s < 8; ++s) {
                const int rr = s * 8 + (lane >> 3), ch = lane & 7;
                const u32x4 w = *(const LAS u32x4*)(tw + rr * 144 + ch * 16);
                *(u32x4*)(dp + (size_t)rr * K + ch * 8) = w;
            }
        }
    }
    __syncthreads();
}

__device__ __forceinline__ void phase_norm(const Params& p, int lpost, int lpre, bool alt = false) {
    int tid_ = threadIdx.x; asm volatile("" : "+v"(tid_));
    const int lane = tid_ & 63, gw = blockIdx.x * 8 + (tid_ >> 6), nw = gridDim.x * 8;
    const float* ADA = (const float*)(p.ws + OFF_ADA);
    const bf16_t* OUTB = (const bf16_t*)(p.ws + OFF_OUT); const bf16_t* XW = (const bf16_t*)(p.ws + OFF_XW);
    bf16_t* HX = (bf16_t*)(p.ws + (alt ? OFF_U : OFF_HX)); bf16_t* XWo = (bf16_t*)(p.ws + (alt ? OFF_HF : OFF_XW));
    const int nrows = lpre < 0 ? MLAT : MTOT;
    for (int row = gw; row < nrows; row += nw) {
        const int bi = row < MLAT ? (row >> 11) : 4;
        float xv[32];
        if (lpost <= 0) {
            const float* xs = row < MLAT ? p.x + (size_t)row * 2048 : p.ctx + (size_t)(row - MLAT) * 2048;
#pragma unroll
            for (int i = 0; i < 4; ++i) { const f32x4 a = *(const f32x4*)(xs + (i * 64 + lane) * 8), b = *(const f32x4*)(xs + (i * 64 + lane) * 8 + 4);
#pragma unroll
                for (int j = 0; j < 4; ++j) { xv[i * 8 + j] = a[j]; xv[i * 8 + 4 + j] = b[j]; } }
        } else {
#pragma unroll
            for (int i = 0; i < 4; ++i) { const u32x4 a = *(const u32x4*)(XW + (size_t)row * 2048 + (i * 64 + lane) * 8);
                xv[i * 8 + 0] = bflo(a.x); xv[i * 8 + 1] = bfhi(a.x); xv[i * 8 + 2] = bflo(a.y); xv[i * 8 + 3] = bfhi(a.y); xv[i * 8 + 4] = bflo(a.z); xv[i * 8 + 5] = bfhi(a.z); xv[i * 8 + 6] = bflo(a.w); xv[i * 8 + 7] = bfhi(a.w); }
        }
        if (lpost >= 0) {
            float o[32]; float ss = 0.f;
#pragma unroll
            for (int i = 0; i < 4; ++i) { const u32x4 a = *(const u32x4*)(OUTB + (size_t)row * 2048 + (i * 64 + lane) * 8);
                o[i * 8 + 0] = bflo(a.x); o[i * 8 + 1] = bfhi(a.x); o[i * 8 + 2] = bflo(a.y); o[i * 8 + 3] = bfhi(a.y); o[i * 8 + 4] = bflo(a.z); o[i * 8 + 5] = bfhi(a.z); o[i * 8 + 6] = bflo(a.w); o[i * 8 + 7] = bfhi(a.w); }
#pragma unroll
            for (int i = 0; i < 32; ++i) ss += o[i] * o[i];
            ss = wave_sum(ss, lane); const float rinv = rsqrtf(ss * (1.0f / 2048.0f) + EPS);
            const float* gt = ADA + (size_t)(lpost * 5 + bi) * 6144 + 4096; const float* gp = p.g_post + lpost * 2048;
#pragma unroll
            for (int i = 0; i < 4; ++i) { const int c = (i * 64 + lane) * 8;
                const f32x4 g0 = *(const f32x4*)(gt + c), g1 = *(const f32x4*)(gt + c + 4), p0 = *(const f32x4*)(gp + c), p1 = *(const f32x4*)(gp + c + 4);
#pragma unroll
                for (int j = 0; j < 4; ++j) { xv[i * 8 + j] += g0[j] * (o[i * 8 + j] * rinv * p0[j]); xv[i * 8 + 4 + j] += g1[j] * (o[i * 8 + 4 + j] * rinv * p1[j]); } }
            if (lpre < 0) {
#pragma unroll
                for (int i = 0; i < 4; ++i) { float* op = p.out + (size_t)row * 2048 + (i * 64 + lane) * 8;
                    *(f32x4*)op = (f32x4){xv[i * 8], xv[i * 8 + 1], xv[i * 8 + 2], xv[i * 8 + 3]}; *(f32x4*)(op + 4) = (f32x4){xv[i * 8 + 4], xv[i * 8 + 5], xv[i * 8 + 6], xv[i * 8 + 7]}; }
                continue;
            }
#pragma unroll
            for (int i = 0; i < 4; ++i) { u32x4 w; w.x = cvt_pk_bf16(xv[i * 8], xv[i * 8 + 1]); w.y = cvt_pk_bf16(xv[i * 8 + 2], xv[i * 8 + 3]); w.z = cvt_pk_bf16(xv[i * 8 + 4], xv[i * 8 + 5]); w.w = cvt_pk_bf16(xv[i * 8 + 6], xv[i * 8 + 7]);
                *(u32x4*)(XWo + (size_t)row * 2048 + (i * 64 + lane) * 8) = w; }
        }
        float ss = 0.f;
#pragma unroll
        for (int i = 0; i < 32; ++i) ss += xv[i] * xv[i];
        ss = wave_sum(ss, lane); const float rinv = rsqrtf(ss * (1.0f / 2048.0f) + EPS);
        const float* sh = ADA + (size_t)(lpre * 5 + bi) * 6144; const float* sc = sh + 2048; const float* g = p.g_pre + lpre * 2048;
#pragma unroll
        for (int i = 0; i < 4; ++i) {
            const int c = (i * 64 + lane) * 8; float hv[8];
#pragma unroll
            for (int hh = 0; hh < 2; ++hh) { const f32x4 s4 = *(const f32x4*)(sh + c + hh * 4), c4 = *(const f32x4*)(sc + c + hh * 4), g4 = *(const f32x4*)(g + c + hh * 4);
#pragma unroll
                for (int j = 0; j < 4; ++j) hv[hh * 4 + j] = xv[i * 8 + hh * 4 + j] * rinv * g4[j] * (c4[j] + 1.0f) + s4[j]; }
            u32x4 w; w.x = cvt_pk_bf16(hv[0], hv[1]); w.y = cvt_pk_bf16(hv[2], hv[3]); w.z = cvt_pk_bf16(hv[4], hv[5]); w.w = cvt_pk_bf16(hv[6], hv[7]);
            *(u32x4*)(HX + (size_t)row * 2048 + c) = w;
        }
    }
}

constexpr int SC_QS = 0, SC_KS = 17408, SC_VT = 34816, SC_VW = 41984, SC_SET = 49152  , SC_P = 98304, SC_CT = 107520, SC_GA = 120576, SC_SC = 157440;
constexpr int QSTR = 272, TSTR = 144, VSTR = 112, NPOS = 2304;
typedef short v4s __attribute__((ext_vector_type(4)));
__device__ __forceinline__ bf16x8 tr_read8(LAS unsigned char* base, int S, int c, int ks, int lane) {
    const int g = lane >> 4, q = (lane >> 2) & 3, pp = lane & 3;
    LAS unsigned char* a0 = base + (32 * ks + 8 * g + q) * S + 32 * c + 8 * pp;
    const v4s lo = __builtin_amdgcn_ds_read_tr16_b64_v4i16((LAS v4s*)a0);
    const v4s hi = __builtin_amdgcn_ds_read_tr16_b64_v4i16((LAS v4s*)(a0 + 4 * S));
    return (bf16x8){lo[0], lo[1], lo[2], lo[3], hi[0], hi[1], hi[2], hi[3]};
}
__device__ __forceinline__ void phase_scan(const Params& p, int l, LAS unsigned char* lds) {
    int tid_ = threadIdx.x; asm volatile("" : "+v"(tid_));
    const int tid = tid_, wid = tid >> 6, lane = tid & 63, fr = lane & 15, fq = lane >> 4;
    const bf16_t* Qg = (const bf16_t*)(p.ws + OFF_Q); const bf16_t* Kg = (const bf16_t*)(p.ws + OFF_K); const bf16_t* Vg = (const bf16_t*)(p.ws + OFF_V);
    const float* Gg = (const float*)(p.ws + OFF_G);
    LAS float* RB = (LAS float*)(lds + SC_GA); LAS float* CS = RB + NPOS; LAS float* EM = CS + NPOS; LAS float* WS = EM + NPOS;
    LAS float* BL = (LAS float*)(lds + SC_SC); LAS float* MG = BL + 36; LAS float* MST = MG + 36; LAS float* MNEW = MST + 36; LAS float* AA = MNEW + 36;
    const bool wr_ctx = l < DEPTH - 1;
    for (int item = blockIdx.x; item < 256; item += gridDim.x) {
        const int xcd = item & 7, idx = item >> 3, bh = xcd * 4 + (idx >> 3), sub = idx & 7, dir = sub >> 2, es = sub & 3, b = bh >> 3, h = bh & 7;
        const int flip = dir ? 63 : 0;
        bf16_t* Hg = (bf16_t*)(p.ws + (dir ? OFF_HB : OFF_HF));
        __syncthreads();
        {
            const float bi_ = p.b_gate[l * 32 + dir * 16 + h], bf_ = p.b_gate[l * 32 + dir * 16 + 8 + h];
            for (int j = wid; j < 36; j += 8) {
                int rb; if (j < 4) { const int oc = dir ? 3 - j : j; rb = MLAT + b * CTXL + oc * 64; } else { const int jl = j - 4, oc = dir ? 31 - jl : jl; rb = b * SEQL + oc * 64; }
                const int row = rb + (lane ^ flip);
                const float gi = Gg[(size_t)(dir * 16 + h) * MTOT + row] + bi_;
                const float gf = Gg[(size_t)(dir * 16 + 8 + h) * MTOT + row] + bf_;
                const float lf = fminf(gf, 0.f) - log1pf(__expf(-fabsf(gf)));
                float bs = lf;
#pragma unroll
                for (int o = 1; o < 64; o <<= 1) { const float t = bperm(bs, (lane - o) & 63); if (lane >= o) bs += t; }
                const float cs = gi - bs;
                float pm = cs;
#pragma unroll
                for (int o = 1; o < 64; o <<= 1) { const float t = bperm(pm, (lane - o) & 63); if (lane >= o) pm = fmaxf(pm, t); }
                const int pi = j * 64 + lane;
                RB[pi] = bs; CS[pi] = cs; EM[pi] = pm;
                const float bl = bperm(bs, 63), pml = bperm(pm, 63);
                if (lane == 0) { BL[j] = bl; MG[j] = bl + pml; }
            }
            __syncthreads();
            if (tid == 0) { float m = NEGV; for (int j = 0; j < 36; ++j) { MST[j] = m; const float mn = fmaxf(BL[j] + m, MG[j]); MNEW[j] = mn; AA[j] = __expf(BL[j] + m - mn); m = mn; } }
            __syncthreads();
            for (int pi = tid; pi < NPOS; pi += 512) {
                const int j = pi >> 6; const float B = RB[pi], pm = EM[pi], cs = CS[pi], mst = MST[j];
                const float mt = B + fmaxf(mst, pm);
                RB[pi] = B - mt; EM[pi] = __expf(-mt); WS[pi] = __expf(BL[j] + cs - MNEW[j]);
            }
            if (tid < 128) { const int s = tid >> 1, hf = tid & 1; unsigned z0 = 0u; asm volatile("" : "+v"(z0)); const u32x4 one = (u32x4){z0 + 0x3F80u, z0, z0, z0}, zz = (u32x4){z0, z0, z0, z0};
                *(LAS u32x4*)(lds + SC_VT + s * VSTR + 64 + hf * 16) = hf ? zz : one; *(LAS u32x4*)(lds + SC_VW + s * VSTR + 64 + hf * 16) = zz;
                *(LAS u32x4*)(lds + SC_SET + SC_VT + s * VSTR + 64 + hf * 16) = hf ? zz : one; *(LAS u32x4*)(lds + SC_SET + SC_VW + s * VSTR + 64 + hf * 16) = zz; }
            __syncthreads();
        }
        f32x4 st[3];
#pragma unroll
        for (int n = 0; n < 3; ++n) st[n] = zero4();
        u32x4 rqA[2], rkA[2], rvA, rqB[2], rkB[2], rvB;
        { unsigned z0 = 0u; asm volatile("" : "+v"(z0)); rvA = (u32x4){z0, z0, z0, z0}; rvB = rvA; }
#define SCAN_ROWBASE(j, rbv) do { if ((j) < 4) { const int oc_ = dir ? 3 - (j) : (j); rbv = MLAT + b * CTXL + oc_ * 64; } else { const int jl_ = (j) - 4, oc_ = dir ? 31 - jl_ : jl_; rbv = b * SEQL + oc_ * 64; } } while (0)
#define SCAN_LOAD(j, rq, rk, rv) do { int rb_; SCAN_ROWBASE(j, rb_); \
        _Pragma("unroll") for (int i = 0; i < 2; ++i) { const int ix = tid + i * 512; rq[i] = *(const u32x4*)(Qg + (size_t)(rb_ + (ix >> 4)) * 1024 + h * 128 + (ix & 15) * 8); \
                                                         rk[i] = *(const u32x4*)(Kg + (size_t)(rb_ + (ix >> 4)) * 1024 + h * 128 + (ix & 15) * 8); } \
        if (tid < 256) rv = *(const u32x4*)(Vg + (size_t)(rb_ + (tid >> 2)) * 1024 + h * 128 + es * 32 + (tid & 3) * 8); } while (0)
#define SCAN_WRITE(j, rq, rk, rv, WB) do { \
        _Pragma("unroll") for (int i = 0; i < 2; ++i) { const int ix = tid + i * 512; *(LAS u32x4*)(lds + (WB) + SC_QS + (ix >> 4) * QSTR + (ix & 15) * 16) = rq[i]; *(LAS u32x4*)(lds + (WB) + SC_KS + (ix >> 4) * QSTR + (ix & 15) * 16) = rk[i]; } \
        if (tid < 256) { const int s_ = tid >> 2; const float ws_ = WS[(j) * 64 + (s_ ^ flip)]; *(LAS u32x4*)(lds + (WB) + SC_VT + s_ * VSTR + (tid & 3) * 16) = rv; \
            u32x4 vw_; vw_.x = cvt_pk_bf16(bflo(rv.x) * ws_, bfhi(rv.x) * ws_); vw_.y = cvt_pk_bf16(bflo(rv.y) * ws_, bfhi(rv.y) * ws_); \
            vw_.z = cvt_pk_bf16(bflo(rv.z) * ws_, bfhi(rv.z) * ws_); vw_.w = cvt_pk_bf16(bflo(rv.w) * ws_, bfhi(rv.w) * ws_); *(LAS u32x4*)(lds + (WB) + SC_VW + s_ * VSTR + (tid & 3) * 16) = vw_; } \
        else if (tid < 320) { const float ws_ = WS[(j) * 64 + (lane ^ flip)]; unsigned z0 = 0u; asm volatile("" : "+v"(z0)); *(LAS u32x4*)(lds + (WB) + SC_VW + lane * VSTR + 64) = (u32x4){cvt_pk_bf16(ws_, 0.f), z0, z0, z0}; } } while (0)
#define SCAN_STEP(jv, LQ, LK, LV, WQ, WK, WV, RBASE, WBASE) do { const int j = (jv); \
            if (j + 2 < 36) SCAN_LOAD(j + 2, LQ, LK, LV); \
            const int g0 = j * 64; \
            const int mt_ = wid & 3, nr = wid >> 2; \
            bf16x8 qf[4]; \
            { \
                const int ms0 = (wid >> 2) * 2; \
                f32x4 sa[2]; sa[0] = zero4(); sa[1] = sa[0]; \
_Pragma("unroll") \
                for (int kk = 0; kk < 4; ++kk) { \
                    qf[kk] = *(const LAS bf16x8*)(lds + (RBASE) + SC_QS + (mt_ * 16 + fr) * QSTR + kk * 64 + fq * 16); \
_Pragma("unroll") \
                    for (int i = 0; i < 2; ++i) { const bf16x8 ak = *(const LAS bf16x8*)(lds + (RBASE) + SC_KS + ((ms0 + i) * 16 + fr) * QSTR + kk * 64 + fq * 16); sa[i] = __builtin_amdgcn_mfma_f32_16x16x32_bf16(ak, qf[kk], sa[i], 0, 0, 0); } \
                } \
                const int t = mt_ * 16 + fr, tp = t ^ flip; const float rbt = RB[g0 + tp]; \
_Pragma("unroll") \
                for (int i = 0; i < 2; ++i) { \
                    const int s0 = (ms0 + i) * 16 + fq * 4; float pv[4]; \
_Pragma("unroll") \
                    for (int jj = 0; jj < 4; ++jj) { const int sp = (s0 + jj) ^ flip; pv[jj] = (sp <= tp) ? sa[i][jj] * __expf(rbt + CS[g0 + sp]) : 0.f; } \
                    u32x2 w; w.x = cvt_pk_bf16(pv[0], pv[1]); w.y = cvt_pk_bf16(pv[2], pv[3]); \
                    *(LAS u32x2*)(lds + SC_P + t * TSTR + s0 * 2) = w; \
                } \
_Pragma("unroll") \
                for (int n = 0; n < 3; ++n) { u32x2 w; w.x = cvt_pk_bf16(st[n][0], st[n][1]); w.y = cvt_pk_bf16(st[n][2], st[n][3]); *(LAS u32x2*)(lds + SC_CT + (n * 16 + fr) * QSTR + (wid * 16 + fq * 4) * 2) = w; } \
            } \
            if (j + 1 < 36) { SCAN_WRITE(j + 1, WQ, WK, WV, WBASE); } \
            __syncthreads(); \
            { \
                f32x4 ar = zero4(), aa = ar; \
_Pragma("unroll") \
                for (int kk = 0; kk < 4; ++kk) { \
                    const bf16x8 br = *(const LAS bf16x8*)(lds + SC_CT + (nr * 16 + fr) * QSTR + kk * 64 + fq * 16); \
                    const bf16x8 ba = *(const LAS bf16x8*)(lds + SC_CT + (32 + fr) * QSTR + kk * 64 + fq * 16); \
                    ar = __builtin_amdgcn_mfma_f32_16x16x32_bf16(qf[kk], br, ar, 0, 0, 0); aa = __builtin_amdgcn_mfma_f32_16x16x32_bf16(qf[kk], ba, aa, 0, 0, 0); \
                } \
                const int t0 = mt_ * 16 + fq * 4; \
_Pragma("unroll") \
                for (int jj = 0; jj < 4; ++jj) { const float wi = __expf(RB[g0 + ((t0 + jj) ^ flip)] + MST[j]); ar[jj] *= wi; aa[jj] *= wi; } \
_Pragma("unroll") \
                for (int kk = 0; kk < 2; ++kk) { \
                    const bf16x8 ap = *(const LAS bf16x8*)(lds + SC_P + (mt_ * 16 + fr) * TSTR + kk * 64 + fq * 16); \
                    const bf16x8 br = tr_read8(lds + (RBASE) + SC_VT, VSTR, nr, kk, lane); \
                    const bf16x8 ba = tr_read8(lds + (RBASE) + SC_VT, VSTR, 2, kk, lane); \
                    ar = __builtin_amdgcn_mfma_f32_16x16x32_bf16(ap, br, ar, 0, 0, 0); aa = __builtin_amdgcn_mfma_f32_16x16x32_bf16(ap, ba, aa, 0, 0, 0); \
                } \
                int rb_; SCAN_ROWBASE(j, rb_); \
                const bool do_wr = (j >= 4) || wr_ctx; \
_Pragma("unroll") \
                for (int jj = 0; jj < 4; ++jj) { \
                    const float den = bperm(aa[jj], lane & 48); const float em = EM[g0 + ((t0 + jj) ^ flip)]; \
                    const float hv = ar[jj] / fmaxf(fabsf(den), em); \
                    const float hn = bperm(hv, lane ^ 1); \
                    if (do_wr && !(fr & 1)) *(unsigned*)(Hg + (size_t)(rb_ + t0 + jj) * 1024 + h * 128 + es * 32 + nr * 16 + fr) = cvt_pk_bf16(hv, hn); \
                } \
                const float aj = AA[j]; \
_Pragma("unroll") \
                for (int n = 0; n < 3; ++n) st[n] *= aj; \
_Pragma("unroll") \
                for (int kk = 0; kk < 2; ++kk) { \
                    const bf16x8 ak = tr_read8(lds + (RBASE) + SC_KS, QSTR, wid, kk, lane); \
_Pragma("unroll") \
                    for (int n = 0; n < 3; ++n) { const bf16x8 bv = tr_read8(lds + (RBASE) + SC_VW, VSTR, n, kk, lane); st[n] = __builtin_amdgcn_mfma_f32_16x16x32_bf16(ak, bv, st[n], 0, 0, 0); } \
                } \
            } \
            __syncthreads(); \
        } while (0)
        SCAN_LOAD(0, rqA, rkA, rvA);
        SCAN_WRITE(0, rqA, rkA, rvA, 0);
        __syncthreads();
        SCAN_LOAD(1, rqA, rkA, rvA);
        for (int j2 = 0; j2 < 36; j2 += 2) {
            SCAN_STEP(j2, rqB, rkB, rvB, rqA, rkA, rvA, 0, SC_SET);
            SCAN_STEP(j2 + 1, rqA, rkA, rvA, rqB, rkB, rvB, SC_SET, 0);
        }
#undef SCAN_STEP
#undef SCAN_ROWBASE
#undef SCAN_LOAD
#undef SCAN_WRITE
    }
}

__device__ __forceinline__ void phase_conv(const Params& p, int l, LAS unsigned char* lds) {
    int tid_ = threadIdx.x; asm volatile("" : "+v"(tid_));
    const int tid = tid_, lane = tid & 63, gw = blockIdx.x * 8 + (tid >> 6), nw = gridDim.x * 8;
    LAS float* wd = (LAS float*)lds;
    __syncthreads();
    for (int i = tid; i < 31 * 256; i += 512) *(LAS f32x4*)(wd + i * 4) = *(const f32x4*)(p.w_dw + (size_t)l * 31 * 1024 + i * 4);
    for (int i = tid; i < 256; i += 512) *(LAS f32x4*)(wd + 31 * 1024 + i * 4) = zero4();
    __syncthreads();
    const bf16_t* __restrict__ U = (const bf16_t*)(p.ws + OFF_U); bf16_t* __restrict__ UC = (bf16_t*)(p.ws + OFF_UC);
    const int cH = lane * 8, cV = 512 + lane * 8;
    const int nrows = l < DEPTH - 1 ? MTOT : MLAT;
    for (int row = gw; row < nrows; row += nw) {
        float acc[16];
        int zl = 0; asm volatile("" : "+v"(zl));
        { const f32x4 b0 = *(const f32x4*)(p.b_dw + l * 1024 + cH + zl), b1 = *(const f32x4*)(p.b_dw + l * 1024 + cH + 4 + zl), b2 = *(const f32x4*)(p.b_dw + l * 1024 + cV + zl), b3 = *(const f32x4*)(p.b_dw + l * 1024 + cV + 4 + zl);
#pragma unroll
          for (int i = 0; i < 4; ++i) { acc[i] = b0[i]; acc[4 + i] = b1[i]; acc[8 + i] = b2[i]; acc[12 + i] = b3[i]; } }
        const bool lat = row < MLAT;
        const int n = lat ? (row & 2047) : ((row - MLAT) & 255);
        const int posH = lat ? (n & 63) : n, limH = lat ? 64 : 256;
        const int posV = lat ? (n >> 6) : n, limV = lat ? 32 : 256, strV = lat ? 64 : 1;
#pragma unroll 1
        for (int jb = 0; jb < 32; jb += 8) {
            u32x4 uH[8], uV[8]; int wH[8], wV[8];
#pragma unroll
            for (int jj = 0; jj < 8; ++jj) {
                const int j = jb + jj, dj = j - 15;
                const bool okH = (j < 31) && ((unsigned)(posH + dj) < (unsigned)limH), okV = (j < 31) && ((unsigned)(posV + dj) < (unsigned)limV);
                const int rH = okH ? row + dj : row, rV = okV ? row + dj * strV : row;
                wH[jj] = (okH ? j : 31) * 1024; wV[jj] = (okV ? j : 31) * 1024;
                uH[jj] = *(const u32x4*)(U + (size_t)rH * 1024 + cH);
                uV[jj] = *(const u32x4*)(U + (size_t)rV * 1024 + cV);
            }
#pragma unroll
            for (int jj = 0; jj < 8; ++jj) {
                { const u32x4 uv = uH[jj]; const f32x4 w0 = *(const LAS f32x4*)(wd + wH[jj] + cH), w1 = *(const LAS f32x4*)(wd + wH[jj] + cH + 4);
                  acc[0] += bflo(uv.x) * w0[0]; acc[1] += bfhi(uv.x) * w0[1]; acc[2] += bflo(uv.y) * w0[2]; acc[3] += bfhi(uv.y) * w0[3];
                  acc[4] += bflo(uv.z) * w1[0]; acc[5] += bfhi(uv.z) * w1[1]; acc[6] += bflo(uv.w) * w1[2]; acc[7] += bfhi(uv.w) * w1[3]; }
                { const u32x4 uv = uV[jj]; const f32x4 w0 = *(const LAS f32x4*)(wd + wV[jj] + cV), w1 = *(const LAS f32x4*)(wd + wV[jj] + cV + 4);
                  acc[8] += bflo(uv.x) * w0[0]; acc[9] += bfhi(uv.x) * w0[1]; acc[10] += bflo(uv.y) * w0[2]; acc[11] += bfhi(uv.y) * w0[3];
                  acc[12] += bflo(uv.z) * w1[0]; acc[13] += bfhi(uv.z) * w1[1]; acc[14] += bflo(uv.w) * w1[2]; acc[15] += bfhi(uv.w) * w1[3]; }
            }
        }
        float s = 0.f;
#pragma unroll
        for (int i = 0; i < 16; ++i) s += acc[i];
        const float mean = wave_sum(s, lane) * (1.0f / 1024.0f);
        float q = 0.f;
#pragma unroll
        for (int i = 0; i < 16; ++i) { acc[i] -= mean; q += acc[i] * acc[i]; }
        const float rstd = rsqrtf(wave_sum(q, lane) * (1.0f / 1024.0f) + EPS);
        float y[16];
        asm volatile("" : "+v"(zl));
#pragma unroll
        for (int hh = 0; hh < 4; ++hh) {
            const int cb = (hh < 2 ? cH : cV) + (hh & 1) * 4;
            const f32x4 g4 = *(const f32x4*)(p.ln_g + l * 1024 + cb + zl), b4 = *(const f32x4*)(p.ln_b + l * 1024 + cb + zl);
#pragma unroll
            for (int i = 0; i < 4; ++i) y[hh * 4 + i] = siluf_(acc[hh * 4 + i] * rstd * g4[i] + b4[i]);
        }
        u32x4 w; w.x = cvt_pk_bf16(y[0], y[1]); w.y = cvt_pk_bf16(y[2], y[3]); w.z = cvt_pk_bf16(y[4], y[5]); w.w = cvt_pk_bf16(y[6], y[7]);
        *(u32x4*)(UC + (size_t)row * 1024 + cH) = w;
        w.x = cvt_pk_bf16(y[8], y[9]); w.y = cvt_pk_bf16(y[10], y[11]); w.z = cvt_pk_bf16(y[12], y[13]); w.w = cvt_pk_bf16(y[14], y[15]);
        *(u32x4*)(UC + (size_t)row * 1024 + cV) = w;
    }
}

__device__ __forceinline__ void phase_mout(const Params& p, int l, int sid, int nside) {
    int tid_ = threadIdx.x; asm volatile("" : "+v"(tid_));
    const int lane = tid_ & 63, gw = sid * 8 + (tid_ >> 6), nw = nside * 8;
    const bf16_t* HF = (const bf16_t*)(p.ws + OFF_HF); const bf16_t* HB = (const bf16_t*)(p.ws + OFF_HB);
    const bf16_t* OG = (const bf16_t*)(p.ws + OFF_OG); bf16_t* CAT = (bf16_t*)(p.ws + OFF_CAT);
    const int nrows = l < DEPTH - 1 ? MTOT : MLAT;
    const int c0 = lane * 16;
    for (int row = gw; row < nrows; row += nw) {
        float hv[16]; float s = 0.f;
#pragma unroll
        for (int i = 0; i < 2; ++i) {
            const u32x4 a = *(const u32x4*)(HF + (size_t)row * 1024 + c0 + i * 8), bb = *(const u32x4*)(HB + (size_t)row * 1024 + c0 + i * 8);
            hv[i * 8 + 0] = bflo(a.x) + bflo(bb.x); hv[i * 8 + 1] = bfhi(a.x) + bfhi(bb.x); hv[i * 8 + 2] = bflo(a.y) + bflo(bb.y); hv[i * 8 + 3] = bfhi(a.y) + bfhi(bb.y);
            hv[i * 8 + 4] = bflo(a.z) + bflo(bb.z); hv[i * 8 + 5] = bfhi(a.z) + bfhi(bb.z); hv[i * 8 + 6] = bflo(a.w) + bflo(bb.w); hv[i * 8 + 7] = bfhi(a.w) + bfhi(bb.w);
        }
#pragma unroll
        for (int i = 0; i < 16; ++i) s += hv[i];
        s += bperm(s, lane ^ 1); s += bperm(s, lane ^ 2); s += bperm(s, lane ^ 4);
        const float mean = s * (1.0f / 128.0f); float q = 0.f;
#pragma unroll
        for (int i = 0; i < 16; ++i) { hv[i] -= mean; q += hv[i] * hv[i]; }
        q += bperm(q, lane ^ 1); q += bperm(q, lane ^ 2); q += bperm(q, lane ^ 4);
        const float rstd = rsqrtf(q * (1.0f / 128.0f) + EPS);
        const u32x4 og0 = *(const u32x4*)(OG + (size_t)row * 1024 + c0), og1 = *(const u32x4*)(OG + (size_t)row * 1024 + c0 + 8);
        const unsigned ogw[8] = {og0.x, og0.y, og0.z, og0.w, og1.x, og1.y, og1.z, og1.w};
        unsigned ow[8];
#pragma unroll
        for (int i = 0; i < 8; ++i) {
            const float g0 = p.g_head[l * 1024 + c0 + 2 * i], g1 = p.g_head[l * 1024 + c0 + 2 * i + 1];
            ow[i] = cvt_pk_bf16(hv[2 * i] * rstd * g0 * bflo(ogw[i]), hv[2 * i + 1] * rstd * g1 * bfhi(ogw[i]));
        }
        *(u32x4*)(CAT + (size_t)row * 2048 + 1024 + c0) = (u32x4){ow[0], ow[1], ow[2], ow[3]};
        *(u32x4*)(CAT + (size_t)row * 2048 + 1024 + c0 + 8) = (u32x4){ow[4], ow[5], ow[6], ow[7]};
    }
}

__global__ void __launch_bounds__(512, 2) fwd_mega(const float* __restrict__ a0, const float* __restrict__ a1, const float* __restrict__ a2, const float* __restrict__ a3,
        const float* __restrict__ a4, const float* __restrict__ a5, const float* __restrict__ a6, const float* __restrict__ a7, const float* __restrict__ a8,
        const float* __restrict__ a9, const float* __restrict__ a10, const float* __restrict__ a11, const float* __restrict__ a12, const float* __restrict__ a13,
        const float* __restrict__ a14, const float* __restrict__ a15, const float* __restrict__ a16, float* outp, unsigned char* wsp, int ph_lo, int ph_hi, int pmode) {
    Params p; p.x = a0; p.c = a1; p.ctx = a2; p.c_ctx = a3; p.w_ada = a4; p.b_ada = a5; p.g_pre = a6; p.g_post = a7; p.w_in = a8; p.b_gate = a9; p.w_dw = a10; p.b_dw = a11;
    p.ln_g = a12; p.ln_b = a13; p.w_pw2 = a14; p.g_head = a15; p.w_out = a16; p.out = outp; p.ws = wsp; p.ph_lo = ph_lo; p.ph_hi = ph_hi;
    extern __shared__ __attribute__((aligned(16))) unsigned char shm[];
    LAS unsigned char* lds = (LAS unsigned char*)shm;
    cg::grid_group grid = cg::this_grid();
    volatile LAS unsigned* xst = (volatile LAS unsigned*)(lds + LDS_BYTES - 16);
    if (threadIdx.x == 0) { xst[0] = 0u; xst[1] = 0u; }
    __syncthreads();
    const XcdBarrier xbar = xcd_barrier_post((unsigned*)(wsp + OFF_BAR), xst);
    if (ph_hi > 1000) grid.sync();
#define GRID_SYNC() xcd_barrier(xbar)
    for (int ph = p.ph_lo; ph < p.ph_hi; ++ph) {
        size_t zoff = 0; asm volatile("" : "+s"(zoff)); unsigned char* ws = p.ws + zoff;
        const int G = (int)gridDim.x, bid = (int)blockIdx.x;
        int tasks = 0, l_ada = 0, l_w = 0, sid = bid, nside = G;
        if (ph == 0) { tasks = 1 | 2; }
        else if (ph == 1) phase_norm(p, -1, 0);
        else if (ph >= 100) { }
        else {
            const int l = (ph - 2) / 5, s = (ph - 2) % 5;
            if (s == 0) {
                EpiIn E; E.ws = ws;
                gemm_phase<EpiIn>(lds, (const bf16_t*)(ws + OFF_HX), (const bf16_t*)(ws + OFF_WIN) + (size_t)l * NINP * 2048, MTOT, NINP, 2048, E);
                const int nun = (MTOT / 256) * (NINP / 256), first_idle = nun % G;
                tasks = 4; l_w = l;
                if (first_idle != 0) { if (bid >= first_idle) { sid = bid - first_idle; nside = G - first_idle; } else tasks = 0; }
            } else if (s == 1) {
                if (pmode != 2) phase_scan(p, l, lds);
                if (pmode != 1) phase_conv(p, l, lds);
            } else if (s == 2) {
                const int Mr = l < DEPTH - 1 ? MTOT : MLAT;
                EpiPw E; E.ws = ws;
                gemm_phase<EpiPw>(lds, (const bf16_t*)(ws + OFF_UC), (const bf16_t*)(ws + OFF_WPW) + (size_t)l * 1024 * 1024, Mr, 1024, 1024, E);
                const int nun = (Mr / 256) * 4;
                if (nun < G) { if (bid >= nun) phase_mout(p, l, bid - nun, G - nun); } else phase_mout(p, l, bid, G);
            } else if (s == 3) {
                const int Mr = l < DEPTH - 1 ? MTOT : MLAT;
                EpiOut E; E.ws = ws;
                gemm_phase<EpiOut>(lds, (const bf16_t*)(ws + OFF_CAT), (const bf16_t*)(ws + OFF_WOUT) + (size_t)l * 2048 * 2048, Mr, 2048, 2048, E);
                if (l < DEPTH - 1) {
                    const int nun = (Mr / 256) * 8, first_idle = nun % G;
                    tasks = 2 | 1; l_w = l + 1; l_ada = l + 1;
                    if (first_idle != 0) { if (bid >= first_idle) { sid = bid - first_idle; nside = G - first_idle; } else tasks = 0; }
                }
            } else {
                phase_norm(p, l, l < DEPTH - 1 ? l + 1 : -1, p.ph_hi - p.ph_lo == 1);
            }
        }
        if (tasks) side_work(p, lds, tasks, l_ada, l_w, sid, nside);
        if (ph + 1 < p.ph_hi) GRID_SYNC();
    }
}

extern "C" void kernel_launch(void* const* d_in, const int* in_sizes, int n_in, void* d_out, int out_size, void* d_ws, size_t ws_size, hipStream_t stream) {
    static int grid_blocks = 0;
    if (grid_blocks == 0) {
        if (n_in != 17 || ws_size < WS_END) { fprintf(stderr, "kernel_launch: unexpected n_in %d or ws_size %zu (need %zu)\n", n_in, ws_size, (size_t)WS_END); grid_blocks = -1; return; }
        int dev = 0, cus = 0, per_cu = 0;
        (void)hipGetDevice(&dev);
        (void)hipDeviceGetAttribute(&cus, hipDeviceAttributeMultiprocessorCount, dev);
        if (hipFuncSetAttribute((const void*)fwd_mega, hipFuncAttributeMaxDynamicSharedMemorySize, LDS_BYTES) != hipSuccess) { fprintf(stderr, "kernel_launch: hipFuncSetAttribute failed\n"); grid_blocks = -1; return; }
        if (hipOccupancyMaxActiveBlocksPerMultiprocessor(&per_cu, (const void*)fwd_mega, 512, LDS_BYTES) != hipSuccess || per_cu < 1) { fprintf(stderr, "kernel_launch: occupancy query says %d\n", per_cu); per_cu = 1; (void)hipGetLastError(); }
        grid_blocks = cus * 1;
        if (grid_blocks <= 0) grid_blocks = 256;
    }
    if (grid_blocks < 0) return;
    Params p{};
    p.x = (const float*)d_in[0]; p.c = (const float*)d_in[1]; p.ctx = (const float*)d_in[2]; p.c_ctx = (const float*)d_in[3];
    p.w_ada = (const float*)d_in[4]; p.b_ada = (const float*)d_in[5]; p.g_pre = (const float*)d_in[6]; p.g_post = (const float*)d_in[7];
    p.w_in = (const float*)d_in[8]; p.b_gate = (const float*)d_in[9]; p.w_dw = (const float*)d_in[10]; p.b_dw = (const float*)d_in[11];
    p.ln_g = (const float*)d_in[12]; p.ln_b = (const float*)d_in[13]; p.w_pw2 = (const float*)d_in[14]; p.g_head = (const float*)d_in[15]; p.w_out = (const float*)d_in[16];
    p.out = (float*)d_out; p.ws = (unsigned char*)d_ws;
    p.ph_lo = 0; p.ph_hi = 2 + 5 * DEPTH;
    if (hipMemsetAsync((char*)d_ws + OFF_BAR, 0, 16384, stream) != hipSuccess) { fprintf(stderr, "kernel_launch: memset of barrier words failed\n"); return; }
    int pmode = 0;
    void* args[] = {&p.x, &p.c, &p.ctx, &p.c_ctx, &p.w_ada, &p.b_ada, &p.g_pre, &p.g_post, &p.w_in, &p.b_gate, &p.w_dw, &p.b_dw, &p.ln_g, &p.ln_b, &p.w_pw2, &p.g_head, &p.w_out, &p.out, &p.ws, &p.ph_lo, &p.ph_hi, &pmode};
    hipError_t e = hipLaunchCooperativeKernel((const void*)fwd_mega, dim3(grid_blocks), dim3(512), args, LDS_BYTES, stream);
    if (e != hipSuccess) fprintf(stderr, "cooperative launch failed: %s (grid %d)\n", hipGetErrorString(e), grid_blocks);
#if PROBE_PH >= 0
    for (int r = 0; r < PROBE_REPS; ++r) {
        p.ph_lo = PROBE_PH % 1000; p.ph_hi = p.ph_lo + 1; pmode = PROBE_PH / 1000;
        (void)hipMemsetAsync((char*)d_ws + OFF_BAR, 0, 16384, stream);
        (void)hipLaunchCooperativeKernel((const void*)fwd_mega, dim3(grid_blocks), dim3(512), args, LDS_BYTES, stream);
    }
#endif
}
```

```cpp
#include <hip/hip_runtime.h>
#include <hip/hip_cooperative_groups.h>
#include <cstdio>
namespace cg = cooperative_groups;

#define LAS __attribute__((address_space(3)))
typedef unsigned short bf16_t;
typedef short bf16x8 __attribute__((ext_vector_type(8)));
typedef float f32x4 __attribute__((ext_vector_type(4)));
typedef unsigned u32x4 __attribute__((ext_vector_type(4)));
typedef unsigned u32x2 __attribute__((ext_vector_type(2)));

constexpr int DM = 2048, SEQL = 2048, DEPTH = 4, CTXL = 256;
constexpr int MLAT = 8192, MTOT = 9216, WCV = 1024, NIN = 8224, NINP = 8448;
constexpr float EPS = 1e-6f, NEGV = -1e30f;
constexpr int LDS_BYTES = 163840;
#ifndef PROBE_PH
#define PROBE_PH -1
#define PROBE_REPS 0
#endif

constexpr size_t SZ_WIN = (size_t)DEPTH * NINP * DM * 2, SZ_WOUT = (size_t)DEPTH * DM * DM * 2, SZ_WPW = (size_t)DEPTH * WCV * WCV * 2;
constexpr size_t SZ_ADA = (size_t)DEPTH * 5 * 6144 * 4, SZ_T2K = (size_t)MTOT * 2048 * 2, SZ_T1K = (size_t)MTOT * 1024 * 2;
constexpr size_t SZ_G = (size_t)MTOT * 32 * 4, SZ_H = (size_t)MTOT * 1024 * 4, SZ_F2K = (size_t)MTOT * 2048 * 4;
constexpr size_t OFF_WIN = 0, OFF_WOUT = OFF_WIN + SZ_WIN, OFF_WPW = OFF_WOUT + SZ_WOUT, OFF_ADA = OFF_WPW + SZ_WPW;
constexpr size_t OFF_HX = OFF_ADA + SZ_ADA, OFF_U = OFF_HX + SZ_T2K, OFF_Z = OFF_U + SZ_T1K, OFF_Q = OFF_Z + SZ_T1K, OFF_K = OFF_Q + SZ_T1K;
constexpr size_t OFF_V = OFF_K + SZ_T1K, OFF_OG = OFF_V + SZ_T1K, OFF_UC = OFF_OG + SZ_T1K, OFF_G = OFF_UC + SZ_T1K;
constexpr size_t OFF_HF = OFF_G + SZ_G, OFF_HB = OFF_HF + SZ_H, OFF_CAT = OFF_HB + SZ_H, OFF_OUT = OFF_CAT + SZ_T2K, OFF_XW = OFF_OUT + SZ_F2K;
constexpr size_t OFF_BAR = OFF_XW + SZ_F2K;
constexpr size_t WS_END = OFF_BAR + 16384;

struct Params {
    const float *x, *c, *ctx, *c_ctx, *w_ada, *b_ada, *g_pre, *g_post, *w_in, *b_gate, *w_dw, *b_dw, *ln_g, *ln_b, *w_pw2, *g_head, *w_out;
    float* out; unsigned char* ws;
    int ph_lo, ph_hi;
};

__device__ __forceinline__ unsigned cvt_pk_bf16(float lo, float hi) { unsigned r; asm("v_cvt_pk_bf16_f32 %0, %1, %2" : "=v"(r) : "v"(lo), "v"(hi)); return r; }
__device__ __forceinline__ f32x4 zero4() { float z = 0.f; asm volatile("" : "+v"(z)); return (f32x4){z, z, z, z}; }
__device__ __forceinline__ float bflo(unsigned w) { return __uint_as_float(w << 16); }
__device__ __forceinline__ float bfhi(unsigned w) { return __uint_as_float(w & 0xffff0000u); }
__device__ __forceinline__ float sigmoidf_(float x) { return __builtin_amdgcn_rcpf(1.0f + __expf(-x)); }
__device__ __forceinline__ float siluf_(float x) { return x * sigmoidf_(x); }
__device__ __forceinline__ float bperm(float v, int srclane) { return __int_as_float(__builtin_amdgcn_ds_bpermute(srclane << 2, __float_as_int(v))); }
__device__ __forceinline__ float wave_sum(float v, int lane) {
#pragma unroll
    for (int o = 32; o >= 1; o >>= 1) v += bperm(v, lane ^ o);
    return v;
}
__host__ __device__ __forceinline__ int perm32(int rho) { const int n = rho >> 4, i = rho & 15; return 8 * (i >> 2) + 4 * n + (i & 3); }
__device__ __forceinline__ int colmap_in(int np) {
    const int pn = np >> 8, within = np & 255, bj = within >> 7, w32 = (within >> 5) & 3, rho = within & 31;
    const int lc = w32 * 32 + perm32(rho);
    if (pn < 8) return (bj ? 1024 : 0) + pn * 128 + lc;
    if (pn < 24) return 2048 + (pn - 8) * 256 + bj * 128 + lc;
    if (pn < 32) return (bj ? 7168 : 6144) + (pn - 24) * 128 + lc;
    return within < 32 ? 8192 + within : -1;
}


#define XB_TMO      128
#define XB_XCNT(j)  (256  + 64 * (j))
#define XB_XSUB(j)  (1280 + 64 * (j))
#define XB_XGEN(j)  (2304 + 64 * (j))
#define XB_TOP      3328
#define XB_TOPGEN   3392
#define XCD_BAR_WORDS 3456
#define XB_SPIN_CAP (1u << 18)
__device__ __forceinline__ unsigned xb_ld(unsigned* p)              { return __hip_atomic_load(p, __ATOMIC_RELAXED, __HIP_MEMORY_SCOPE_AGENT); }
__device__ __forceinline__ unsigned xb_add(unsigned* p, unsigned v) { return __hip_atomic_fetch_add(p, v, __ATOMIC_RELAXED, __HIP_MEMORY_SCOPE_AGENT); }
__device__ __forceinline__ unsigned xb_xcc_id() { return (unsigned)__builtin_amdgcn_s_getreg((3 << 11) | 20) & 0xFu; }
#define XB_SPIN(cond, bar) do { unsigned _sp = 0; while (cond) { __builtin_amdgcn_s_sleep(1); \
    if ((++_sp & 255u) == 0u) { if (xb_ld(&(bar)[XB_TMO])) break; if (_sp > XB_SPIN_CAP) { atomicAdd(&(bar)[XB_TMO], 1u); break; } } } } while (0)
struct XcdBarrier { unsigned* bar; unsigned x; volatile LAS unsigned* st; };
__device__ __forceinline__ XcdBarrier xcd_barrier_post(unsigned* bar, volatile LAS unsigned* st) {
    XcdBarrier b; b.bar = bar; b.x = xb_xcc_id(); b.st = st;
    if (threadIdx.x == 0) (void)xb_add(&bar[XB_XCNT(b.x)], 1u);
    return b;
}
__device__ __forceinline__ void xcd_barrier_complete(unsigned* bar, unsigned x, unsigned& nloc, unsigned& nx) {
    const unsigned G = gridDim.x * gridDim.y * gridDim.z;
    unsigned sum, cnt, mine, sp = 0u;
    for (;;) {
        sum = 0u; cnt = 0u; mine = 0u;
#pragma unroll
        for (unsigned j = 0; j < 16; ++j) { const unsigned c = xb_ld(&bar[XB_XCNT(j)]); sum += c; cnt += (c > 0u) ? 1u : 0u; mine = (j == x) ? c : mine; }
        if (sum == G) break;
        __builtin_amdgcn_s_sleep(1);
        if ((++sp & 255u) == 0u) { if (xb_ld(&bar[XB_TMO])) break; if (sp > XB_SPIN_CAP) { atomicAdd(&bar[XB_TMO], 1u); break; } }
    }
    nloc = mine > 0u ? mine : 1u; nx = cnt > 0u ? cnt : 1u;
}
__device__ __forceinline__ void xcd_barrier(const XcdBarrier& b) {
    asm volatile("s_waitcnt vmcnt(0)" ::: "memory");
    __syncthreads();
    if (threadIdx.x == 0) {
        unsigned* bar = b.bar;
        __builtin_amdgcn_s_waitcnt(0);
        unsigned nloc = b.st[0], nx = b.st[1];
        if (nloc == 0u) { xcd_barrier_complete(bar, b.x, nloc, nx); b.st[0] = nloc; b.st[1] = nx; }
        const unsigned old = xb_add(&bar[XB_XSUB(b.x)], 1u);
        const unsigned gen = old / nloc;
        if (old + 1u == (gen + 1u) * nloc) {
            __builtin_amdgcn_fence(__ATOMIC_RELEASE, "agent");
            asm volatile("s_waitcnt vmcnt(0)" ::: "memory");
            const unsigned og = xb_add(&bar[XB_TOP], 1u);
            const unsigned tg = og / nx;
            if (og + 1u == (tg + 1u) * nx) xb_add(&bar[XB_TOPGEN], 1u);
            else XB_SPIN(xb_ld(&bar[XB_TOPGEN]) == tg, bar);
            __builtin_amdgcn_fence(__ATOMIC_ACQUIRE, "agent");
            xb_add(&bar[XB_XGEN(b.x)], 1u);
            asm volatile("s_waitcnt vmcnt(0)" ::: "memory");
        } else {
            XB_SPIN(xb_ld(&bar[XB_XGEN(b.x)]) == gen, bar);
            __builtin_amdgcn_fence(__ATOMIC_ACQUIRE, "agent");
            asm volatile("s_waitcnt vmcnt(0)" ::: "memory");
        }
    }
    __syncthreads();
}

constexpr int BM = 256, BK = 64, HALF = 128, HTB = HALF * BK * 2, NXCD = 8, WGM = 8;
__host__ __device__ __forceinline__ int lds_byte(int r, int c) { const int st = (r >> 4) * 2 + (c >> 5), rr = r & 15, cc = c & 31, ob = rr * 64 + cc * 2; return st * 1024 + (ob ^ (((ob >> 9) & 1) << 5)); }
__host__ __device__ __forceinline__ void stage_rc(int b, int& R, int& C) { const int st = b / 1024, sb = b % 1024, swz = sb ^ (((sb >> 9) & 1) << 5); R = (st >> 1) * 16 + swz / 64; C = (st & 1) * 32 + (swz % 64) / 2; }
struct Unit { int pm, pn; };
struct StaticOrder {
    int nM, nN, nwg, G, c;
    __device__ void init(int M, int N, int G_, int c_) { nM = M / BM; nN = N / BM; nwg = nM * nN; G = G_; c = c_; }
    __device__ bool next(int i, Unit& u) const {
        const long L = (long)i * G + c; if (L >= nwg) return false;
        int wgid = (int)L; { const int q = nwg / NXCD, r = nwg % NXCD, xcd = wgid % NXCD, off = wgid / NXCD; wgid = (xcd < r ? xcd * (q + 1) : r * (q + 1) + (xcd - r) * q) + off; }
        const int nig = WGM * nN, gid = wgid / nig, fm = gid * WGM, gsz = (nM - fm) < WGM ? (nM - fm) : WGM;
        u.pm = fm + ((wgid % nig) % gsz); u.pn = (wgid % nig) / gsz; return true;
    }
};

template <class Epi>
__device__ __forceinline__ void gemm_phase(LAS unsigned char* lds, const bf16_t* gA, const bf16_t* gBt, int M, int N, int K, const Epi E) {
    int tid_ = threadIdx.x; asm volatile("" : "+v"(tid_));
    const int tid = tid_, wid = __builtin_amdgcn_readfirstlane(tid >> 6), lane = tid & 63, wr = wid >> 2, wc = wid & 3, fr = lane & 15, fq = lane >> 4;
    const int nt = K / BK;
    StaticOrder S; S.init(M, N, (int)gridDim.x, (int)blockIdx.x);
    unsigned voffA[2];
#pragma unroll
    for (int i = 0; i < 2; ++i) { int R, C; stage_rc(tid * 16 + i * 8192, R, C); voffA[i] = (unsigned)(R * K + C) * 2u; }
    const size_t kstep = (size_t)(BK * 2);
    const size_t hstep = (size_t)HALF * K * 2;
    const size_t tstep = 2 * hstep;
    const unsigned ldsw = (unsigned)wid * 1024u;
    const int aoff = lds_byte(wr * 64 + fr, fq * 8), boff = lds_byte(wc * 32 + fr, fq * 8);
#define PG8_SA(b, h) (((b) * 2 + (h)) * HTB)
#define PG8_SB(b, h) ((4 + (b) * 2 + (h)) * HTB)
#define PG8_STAGE(bufoff, gbase, voff) do { _Pragma("unroll") for (int _i = 0; _i < 2; ++_i) \
        __builtin_amdgcn_global_load_lds((const unsigned*)((const char*)(gbase) + (voff)[_i]), (LAS unsigned*)(lds + (bufoff) + ldsw + _i * 8192), 16, 0, 0); } while (0)
#define PG8_LDA(dst, b, h) do { _Pragma("unroll") for (int m = 0; m < 4; ++m) _Pragma("unroll") for (int k = 0; k < 2; ++k) dst[m][k] = *(const LAS bf16x8*)(lds + PG8_SA(b, h) + aoff + m * 2048 + k * 1024); } while (0)
#define PG8_LDB(dst, b, h) do { _Pragma("unroll") for (int n = 0; n < 2; ++n) _Pragma("unroll") for (int k = 0; k < 2; ++k) dst[n][k] = *(const LAS bf16x8*)(lds + PG8_SB(b, h) + boff + n * 2048 + k * 1024); } while (0)
#define PG8_MMA(ai, bj, At, Bt) do { __builtin_amdgcn_s_setprio(1); _Pragma("unroll") for (int m = 0; m < 4; ++m) _Pragma("unroll") for (int n = 0; n < 2; ++n) _Pragma("unroll") for (int k = 0; k < 2; ++k) \
        acc[ai][bj][m][n] = __builtin_amdgcn_mfma_f32_16x16x32_bf16(Bt[n][k], At[m][k], acc[ai][bj][m][n], 0, 0, 0); __builtin_amdgcn_s_setprio(0); } while (0)
#define PG8_WAIT_V(n) asm volatile("s_waitcnt vmcnt(" #n ")" ::: "memory")
#define PG8_WAIT_L(n) asm volatile("s_waitcnt lgkmcnt(" #n ")" ::: "memory")
#define PG8_BAR __builtin_amdgcn_s_barrier()
#define PG8_SCHED __builtin_amdgcn_sched_barrier(0)
    Unit cur, nxt; int ui = 0;
    if (!S.next(0, cur)) return;
    f32x4 acc[2][2][4][2];
#pragma unroll
    for (int a = 0; a < 2; ++a)
#pragma unroll
        for (int b = 0; b < 2; ++b)
#pragma unroll
            for (int m = 0; m < 4; ++m)
#pragma unroll
                for (int n = 0; n < 2; ++n) acc[a][b][m][n] = zero4();
    bf16x8 At[4][2], B0[2][2], B1[2][2];
    const char* cA = (const char*)gA + (size_t)cur.pm * tstep; const char* cB = (const char*)gBt + (size_t)cur.pn * tstep;
    PG8_STAGE(PG8_SB(0, 0), cB, voffA); PG8_STAGE(PG8_SA(0, 0), cA, voffA); PG8_STAGE(PG8_SB(0, 1), cB + hstep, voffA); PG8_STAGE(PG8_SA(0, 1), cA + hstep, voffA);
    if (wr == 1) PG8_BAR;
    PG8_WAIT_V(4); PG8_BAR;
    PG8_STAGE(PG8_SB(1, 0), cB + kstep, voffA); PG8_STAGE(PG8_SA(1, 0), cA + kstep, voffA); PG8_STAGE(PG8_SB(1, 1), cB + hstep + kstep, voffA);
    PG8_WAIT_V(6); PG8_BAR;
    for (;;) {
        const bool has_next = S.next(ui + 1, nxt);
        const char* nA = has_next ? (const char*)gA + (size_t)nxt.pm * tstep : cA; const char* nB = has_next ? (const char*)gBt + (size_t)nxt.pn * tstep : cB;
        for (int t = 0; t < nt; t += 2) {
            const bool last = (t == nt - 2);
            const char* a1 = cA + (size_t)(t + 1) * kstep;
            const char* a2 = last ? nA : cA + (size_t)(t + 2) * kstep; const char* b2 = last ? nB : cB + (size_t)(t + 2) * kstep;
            const char* a3 = a2 + kstep; const char* b3 = b2 + kstep;
            PG8_LDB(B0, 0, 0); PG8_SCHED; PG8_LDA(At, 0, 0); PG8_STAGE(PG8_SA(1, 1), a1 + hstep, voffA);
            PG8_WAIT_L(8); PG8_BAR; PG8_WAIT_L(0); PG8_MMA(0, 0, At, B0); PG8_BAR; PG8_SCHED;
            PG8_LDB(B1, 0, 1); PG8_STAGE(PG8_SB(0, 0), b2, voffA);
            PG8_BAR; PG8_WAIT_L(0); PG8_MMA(0, 1, At, B1); PG8_BAR;
            PG8_LDA(At, 0, 1); PG8_STAGE(PG8_SA(0, 0), a2, voffA);
            PG8_BAR; PG8_WAIT_L(0); PG8_MMA(1, 0, At, B0); PG8_BAR; PG8_SCHED;
            PG8_STAGE(PG8_SB(0, 1), b2 + hstep, voffA);
            PG8_WAIT_V(6); PG8_BAR; PG8_MMA(1, 1, At, B1); PG8_BAR;
            PG8_LDB(B0, 1, 0); PG8_SCHED; PG8_LDA(At, 1, 0); PG8_STAGE(PG8_SA(0, 1), a2 + hstep, voffA);
            PG8_WAIT_L(8); PG8_BAR; PG8_WAIT_L(0); PG8_MMA(0, 0, At, B0); PG8_BAR; PG8_SCHED;
            PG8_LDB(B1, 1, 1); PG8_STAGE(PG8_SB(1, 0), b3, voffA);
            PG8_BAR; PG8_WAIT_L(0); PG8_MMA(0, 1, At, B1); PG8_BAR;
            PG8_LDA(At, 1, 1); PG8_STAGE(PG8_SA(1, 0), a3, voffA);
            PG8_BAR; PG8_WAIT_L(0); PG8_MMA(1, 0, At, B0); PG8_BAR; PG8_SCHED;
            PG8_STAGE(PG8_SB(1, 1), b3 + hstep, voffA);
            PG8_WAIT_V(6); PG8_BAR; PG8_MMA(1, 1, At, B1); PG8_BAR;
        }
        E(acc, cur, wr, wc, fr, fq);
        if (!has_next) break;
#pragma unroll
        for (int a = 0; a < 2; ++a)
#pragma unroll
            for (int b = 0; b < 2; ++b)
#pragma unroll
                for (int m = 0; m < 4; ++m)
#pragma unroll
                    for (int n = 0; n < 2; ++n) acc[a][b][m][n] = zero4();
        cur = nxt; cA = nA; cB = nB; ++ui;
    }
    PG8_WAIT_V(0);
    if (wr == 0) PG8_BAR;
    PG8_BAR;
#undef PG8_SA
#undef PG8_SB
#undef PG8_STAGE
#undef PG8_LDA
#undef PG8_LDB
#undef PG8_MMA
#undef PG8_WAIT_V
#undef PG8_WAIT_L
#undef PG8_BAR
#undef PG8_SCHED
}

struct EpiIn {
    unsigned char* ws;
    __device__ __forceinline__ void operator()(const f32x4 (&acc)[2][2][4][2], const Unit& u, int wr, int wc, int fr, int fq) const {
        bf16_t* const U = (bf16_t*)(ws + OFF_U); bf16_t* const Z = (bf16_t*)(ws + OFF_Z); bf16_t* const Q = (bf16_t*)(ws + OFF_Q); bf16_t* const Kp = (bf16_t*)(ws + OFF_K);
        bf16_t* const V = (bf16_t*)(ws + OFF_V); bf16_t* const OG = (bf16_t*)(ws + OFF_OG); float* const G = (float*)(ws + OFF_G);
        const int row0 = u.pm * BM + wr * 64 + fr, pn = u.pn, lc0 = wc * 32 + 8 * fq;
        if (pn < 8 || (pn >= 24 && pn < 32)) {
            const bool glu = pn < 8;
            bf16_t* dst = glu ? U : OG; const int colb = (glu ? pn : pn - 24) * 128 + lc0;
#pragma unroll
            for (int ai = 0; ai < 2; ++ai)
#pragma unroll
                for (int m = 0; m < 4; ++m) {
                    const size_t r = (size_t)(row0 + ai * HALF + m * 16);
                    float o[8];
#pragma unroll
                    for (int n = 0; n < 2; ++n)
#pragma unroll
                        for (int j = 0; j < 4; ++j) {
                            const float a = acc[ai][0][m][n][j], g = acc[ai][1][m][n][j];
                            o[n * 4 + j] = glu ? a * sigmoidf_(g) : sigmoidf_(a) * siluf_(g);
                        }
                    u32x4 w; w.x = cvt_pk_bf16(o[0], o[1]); w.y = cvt_pk_bf16(o[2], o[3]); w.z = cvt_pk_bf16(o[4], o[5]); w.w = cvt_pk_bf16(o[6], o[7]);
                    *(u32x4*)(dst + r * 1024 + colb) = w;
                }
        } else if (pn < 24) {
            const int t = (pn - 8) >> 2;
            bf16_t* dst = t == 0 ? Z : (t == 1 ? Q : (t == 2 ? Kp : V));
            const int colb = ((pn - 8) & 3) * 256 + lc0;
            const float qs = 0.08838834764831845f;
#pragma unroll
            for (int ai = 0; ai < 2; ++ai)
#pragma unroll
                for (int m = 0; m < 4; ++m) {
                    const size_t r = (size_t)(row0 + ai * HALF + m * 16);
#pragma unroll
                    for (int bj = 0; bj < 2; ++bj) {
                        float o[8];
#pragma unroll
                        for (int n = 0; n < 2; ++n)
#pragma unroll
                            for (int j = 0; j < 4; ++j) {
                                const float a = acc[ai][bj][m][n][j];
                                o[n * 4 + j] = t == 0 ? siluf_(a) : (t == 1 ? a * qs : a);
                            }
                        u32x4 w; w.x = cvt_pk_bf16(o[0], o[1]); w.y = cvt_pk_bf16(o[2], o[3]); w.z = cvt_pk_bf16(o[4], o[5]); w.w = cvt_pk_bf16(o[6], o[7]);
                        *(u32x4*)(dst + r * 1024 + colb + bj * HALF) = w;
                    }
                }
        } else {
            if (wc == 0) {
#pragma unroll
                for (int ai = 0; ai < 2; ++ai)
#pragma unroll
                    for (int m = 0; m < 4; ++m) {
                        const size_t r = (size_t)(row0 + ai * HALF + m * 16);
#pragma unroll
                        for (int n = 0; n < 2; ++n)
#pragma unroll
                            for (int j = 0; j < 4; ++j) G[(size_t)(16 * n + 4 * fq + j) * MTOT + r] = acc[ai][0][m][n][j];
                    }
            }
        }
    }
};
struct EpiPw {
    unsigned char* ws;
    __device__ __forceinline__ void operator()(const f32x4 (&acc)[2][2][4][2], const Unit& u, int wr, int wc, int fr, int fq) const {
        const bf16_t* __restrict__ const Z = (const bf16_t*)(ws + OFF_Z); bf16_t* __restrict__ const CAT = (bf16_t*)(ws + OFF_CAT);
        const int row0 = u.pm * BM + wr * 64 + fr, colb = u.pn * BM + wc * 64 + 8 * fq;
#pragma unroll
        for (int ai = 0; ai < 2; ++ai) {
            u32x4 zz[4][2];
#pragma unroll
            for (int m = 0; m < 4; ++m)
#pragma unroll
                for (int bj = 0; bj < 2; ++bj) zz[m][bj] = *(const u32x4*)(Z + (size_t)(row0 + ai * HALF + m * 16) * 1024 + colb + bj * 32);
#pragma unroll
            for (int m = 0; m < 4; ++m) {
                const size_t r = (size_t)(row0 + ai * HALF + m * 16);
#pragma unroll
                for (int bj = 0; bj < 2; ++bj) {
                    const u32x4 z = zz[m][bj];
                    const f32x4 v0 = acc[ai][bj][m][0], v1 = acc[ai][bj][m][1];
                    u32x4 w;
                    w.x = cvt_pk_bf16(v0[0] * bflo(z.x), v0[1] * bfhi(z.x)); w.y = cvt_pk_bf16(v0[2] * bflo(z.y), v0[3] * bfhi(z.y));
                    w.z = cvt_pk_bf16(v1[0] * bflo(z.z), v1[1] * bfhi(z.z)); w.w = cvt_pk_bf16(v1[2] * bflo(z.w), v1[3] * bfhi(z.w));
                    *(u32x4*)(CAT + r * 2048 + colb + bj * 32) = w;
                }
            }
        }
    }
};
struct EpiOut {
    unsigned char* ws;
    __device__ __forceinline__ void operator()(const f32x4 (&acc)[2][2][4][2], const Unit& u, int wr, int wc, int fr, int fq) const {
        bf16_t* const O = (bf16_t*)(ws + OFF_OUT);
        const int row0 = u.pm * BM + wr * 64 + fr, colb = u.pn * BM + wc * 64 + 8 * fq;
#pragma unroll
        for (int ai = 0; ai < 2; ++ai)
#pragma unroll
            for (int m = 0; m < 4; ++m) {
                const size_t r = (size_t)(row0 + ai * HALF + m * 16);
#pragma unroll
                for (int bj = 0; bj < 2; ++bj) {
                    const f32x4 v0 = acc[ai][bj][m][0], v1 = acc[ai][bj][m][1];
                    u32x4 w; w.x = cvt_pk_bf16(v0[0], v0[1]); w.y = cvt_pk_bf16(v0[2], v0[3]); w.z = cvt_pk_bf16(v1[0], v1[1]); w.w = cvt_pk_bf16(v1[2], v1[3]);
                    *(u32x4*)(O + r * 2048 + colb + bj * 32) = w;
                }
            }
    }
};

__device__ __forceinline__ void side_work(const Params& p, LAS unsigned char* lds, int tasks, int l_ada, int l_w, int sid, int nside) {
    int tid_ = threadIdx.x; asm volatile("" : "+v"(tid_));
    const int tid = tid_, wid = tid >> 6, lane = tid & 63;
    LAS float* s5 = (LAS float*)lds;
    LAS float* red = (LAS float*)(lds + 40960);
    __syncthreads();
    if (tasks & 1) {
        for (int i = tid; i < 5 * 2048; i += 512) { const int r = i >> 11, k = i & 2047; const float v = r < 4 ? p.c[r * 2048 + k] : p.c_ctx[k]; s5[i] = siluf_(v); }
        __syncthreads();
        float* ADA = (float*)(p.ws + OFF_ADA);
        const int l = l_ada;
        for (int item = sid; item < 192; item += nside) {
            const int cq = lane & 7, kq = lane >> 3, col0 = item * 32;
            const float* w = p.w_ada + (size_t)l * 2048 * 6144 + col0 + cq * 4;
            f32x4 a0 = zero4(), a1 = a0, a2 = a0, a3 = a0, a4 = a0;
            const int k0 = wid * 256 + kq;
#pragma unroll 1
            for (int ib = 0; ib < 32; ib += 4) {
                f32x4 wv[4];
#pragma unroll
                for (int i = 0; i < 4; ++i) wv[i] = __builtin_nontemporal_load((const f32x4*)(w + (size_t)(k0 + 8 * (ib + i)) * 6144));
#pragma unroll
                for (int i = 0; i < 4; ++i) { const int k = k0 + 8 * (ib + i);
                    a0 += wv[i] * s5[k]; a1 += wv[i] * s5[2048 + k]; a2 += wv[i] * s5[4096 + k]; a3 += wv[i] * s5[6144 + k]; a4 += wv[i] * s5[8192 + k]; }
            }
#pragma unroll
            for (int j = 0; j < 4; ++j) {
#pragma unroll
                for (int o = 8; o < 64; o <<= 1) { a0[j] += bperm(a0[j], lane ^ o); a1[j] += bperm(a1[j], lane ^ o); a2[j] += bperm(a2[j], lane ^ o); a3[j] += bperm(a3[j], lane ^ o); a4[j] += bperm(a4[j], lane ^ o); }
            }
            if (lane < 8) {
                *(LAS f32x4*)(red + (wid * 5 + 0) * 32 + cq * 4) = a0; *(LAS f32x4*)(red + (wid * 5 + 1) * 32 + cq * 4) = a1; *(LAS f32x4*)(red + (wid * 5 + 2) * 32 + cq * 4) = a2;
                *(LAS f32x4*)(red + (wid * 5 + 3) * 32 + cq * 4) = a3; *(LAS f32x4*)(red + (wid * 5 + 4) * 32 + cq * 4) = a4;
            }
            __syncthreads();
            if (tid < 160) {
                const int r = tid >> 5, cl = tid & 31, cc = col0 + cl; float s = p.b_ada[l * 6144 + cc];
#pragma unroll
                for (int w8 = 0; w8 < 8; ++w8) s += red[(w8 * 5 + r) * 32 + cl];
                ADA[(size_t)(l * 5 + r) * 6144 + cc] = s;
            }
            __syncthreads();
        }
    }
    constexpr int NT_IN = (NINP / 64) * 32, NT_OUT = 32 * 32, NT_PW = 16 * 16;
    if (tasks & 6) {
        const int t_lo = (tasks & 2) ? 0 : NT_IN, t_hi = (tasks & 4) ? NT_IN + NT_OUT + NT_PW : NT_IN;
        const int l = l_w;
        for (int t = t_lo + sid * 8 + wid; t < t_hi; t += nside * 8) {
            const float* src; bf16_t* dst; int NS, K, nb, kb, kind;
            if (t < NT_IN) { kb = t / 132; nb = t % 132; src = p.w_in + (size_t)l * 2048 * NIN; NS = NIN; K = 2048; dst = (bf16_t*)(p.ws + OFF_WIN) + (size_t)l * NINP * 2048; kind = 0; }
            else if (t < NT_IN + NT_OUT) { const int t2 = t - NT_IN; kb = t2 / 32; nb = t2 % 32; src = p.w_out + (size_t)l * 2048 * 2048; NS = 2048; K = 2048; dst = (bf16_t*)(p.ws + OFF_WOUT) + (size_t)l * 2048 * 2048; kind = 1; }
            else { const int t3 = t - NT_IN - NT_OUT; kb = t3 / 16; nb = t3 % 16; src = p.w_pw2 + (size_t)l * 1024 * 1024; NS = 1024; K = 1024; dst = (bf16_t*)(p.ws + OFF_WPW) + (size_t)l * 1024 * 1024; kind = 2; }
            const int np = nb * 64 + lane;
            const int col = kind == 0 ? colmap_in(np) : (np & ~255) + ((np >> 5) & 3) * 64 + ((np >> 7) & 1) * 32 + perm32(np & 31);
            const float* sp = src + (size_t)(kb * 64) * NS + (col >= 0 ? col : 0);
            float v[64];
#pragma unroll
            for (int i = 0; i < 64; ++i) v[i] = __builtin_nontemporal_load(sp + (size_t)i * NS);
            if (col < 0) {
#pragma unroll
                for (int i = 0; i < 64; ++i) v[i] = 0.f;
            }
            LAS unsigned char* tw = lds + 51200 + wid * 9216;
#pragma unroll
            for (int j = 0; j < 8; ++j) {
                u32x4 w; w.x = cvt_pk_bf16(v[8 * j], v[8 * j + 1]); w.y = cvt_pk_bf16(v[8 * j + 2], v[8 * j + 3]); w.z = cvt_pk_bf16(v[8 * j + 4], v[8 * j + 5]); w.w = cvt_pk_bf16(v[8 * j + 6], v[8 * j + 7]);
                *(LAS u32x4*)(tw + lane * 144 + j * 16) = w;
            }
            bf16_t* dp = dst + (size_t)(nb * 64) * K + kb * 64;
#pragma unroll
            for (int s = 0; s < 8; ++s) {
                const int rr = s * 8 + (lane >> 3), ch = lane & 7;
                const u32x4 w = *(const LAS u32x4*)(tw + rr * 144 + ch * 16);
                *(u32x4*)(dp + (size_t)rr * K + ch * 8) = w;
            }
        }
    }
    __syncthreads();
}

__device__ __forceinline__ void phase_norm(const Params& p, int lpost, int lpre, bool alt = false) {
    int tid_ = threadIdx.x; asm volatile("" : "+v"(tid_));
    const int lane = tid_ & 63, gw = blockIdx.x * 8 + (tid_ >> 6), nw = gridDim.x * 8;
    const float* ADA = (const float*)(p.ws + OFF_ADA);
    const bf16_t* OUTB = (const bf16_t*)(p.ws + OFF_OUT); const bf16_t* XW = (const bf16_t*)(p.ws + OFF_XW);
    bf16_t* HX = (bf16_t*)(p.ws + (alt ? OFF_U : OFF_HX)); bf16_t* XWo = (bf16_t*)(p.ws + (alt ? OFF_HF : OFF_XW));
    const int nrows = lpre < 0 ? MLAT : MTOT;
    for (int row = gw; row < nrows; row += nw) {
        const int bi = row < MLAT ? (row >> 11) : 4;
        float xv[32];
        if (lpost <= 0) {
            const float* xs = row < MLAT ? p.x + (size_t)row * 2048 : p.ctx + (size_t)(row - MLAT) * 2048;
#pragma unroll
            for (int i = 0; i < 4; ++i) { const f32x4 a = *(const f32x4*)(xs + (i * 64 + lane) * 8), b = *(const f32x4*)(xs + (i * 64 + lane) * 8 + 4);
#pragma unroll
                for (int j = 0; j < 4; ++j) { xv[i * 8 + j] = a[j]; xv[i * 8 + 4 + j] = b[j]; } }
        } else {
#pragma unroll
            for (int i = 0; i < 4; ++i) { const u32x4 a = *(const u32x4*)(XW + (size_t)row * 2048 + (i * 64 + lane) * 8);
                xv[i * 8 + 0] = bflo(a.x); xv[i * 8 + 1] = bfhi(a.x); xv[i * 8 + 2] = bflo(a.y); xv[i * 8 + 3] = bfhi(a.y); xv[i * 8 + 4] = bflo(a.z); xv[i * 8 + 5] = bfhi(a.z); xv[i * 8 + 6] = bflo(a.w); xv[i * 8 + 7] = bfhi(a.w); }
        }
        if (lpost >= 0) {
            float o[32]; float ss = 0.f;
#pragma unroll
            for (int i = 0; i < 4; ++i) { const u32x4 a = *(const u32x4*)(OUTB + (size_t)row * 2048 + (i * 64 + lane) * 8);
                o[i * 8 + 0] = bflo(a.x); o[i * 8 + 1] = bfhi(a.x); o[i * 8 + 2] = bflo(a.y); o[i * 8 + 3] = bfhi(a.y); o[i * 8 + 4] = bflo(a.z); o[i * 8 + 5] = bfhi(a.z); o[i * 8 + 6] = bflo(a.w); o[i * 8 + 7] = bfhi(a.w); }
#pragma unroll
            for (int i = 0; i < 32; ++i) ss += o[i] * o[i];
            ss = wave_sum(ss, lane); const float rinv = rsqrtf(ss * (1.0f / 2048.0f) + EPS);
            const float* gt = ADA + (size_t)(lpost * 5 + bi) * 6144 + 4096; const float* gp = p.g_post + lpost * 2048;
#pragma unroll
            for (int i = 0; i < 4; ++i) { const int c = (i * 64 + lane) * 8;
                const f32x4 g0 = *(const f32x4*)(gt + c), g1 = *(const f32x4*)(gt + c + 4), p0 = *(const f32x4*)(gp + c), p1 = *(const f32x4*)(gp + c + 4);
#pragma unroll
                for (int j = 0; j < 4; ++j) { xv[i * 8 + j] += g0[j] * (o[i * 8 + j] * rinv * p0[j]); xv[i * 8 + 4 + j] += g1[j] * (o[i * 8 + 4 + j] * rinv * p1[j]); } }
            if (lpre < 0) {
#pragma unroll
                for (int i = 0; i < 4; ++i) { float* op = p.out + (size_t)row * 2048 + (i * 64 + lane) * 8;
                    *(f32x4*)op = (f32x4){xv[i * 8], xv[i * 8 + 1], xv[i * 8 + 2], xv[i * 8 + 3]}; *(f32x4*)(op + 4) = (f32x4){xv[i * 8 + 4], xv[i * 8 + 5], xv[i * 8 + 6], xv[i * 8 + 7]}; }
                continue;
            }
#pragma unroll
            for (int i = 0; i < 4; ++i) { u32x4 w; w.x = cvt_pk_bf16(xv[i * 8], xv[i * 8 + 1]); w.y = cvt_pk_bf16(xv[i * 8 + 2], xv[i * 8 + 3]); w.z = cvt_pk_bf16(xv[i * 8 + 4], xv[i * 8 + 5]); w.w = cvt_pk_bf16(xv[i * 8 + 6], xv[i * 8 + 7]);
                *(u32x4*)(XWo + (size_t)row * 2048 + (i * 64 + lane) * 8) = w; }
        }
        float ss = 0.f;
#pragma unroll
        for (int i = 0; i < 32; ++i) ss += xv[i] * xv[i];
        ss = wave_sum(ss, lane); const float rinv = rsqrtf(ss * (1.0f / 2048.0f) + EPS);
        const float* sh = ADA + (size_t)(lpre * 5 + bi) * 6144; const float* sc = sh + 2048; const float* g = p.g_pre + lpre * 2048;
#pragma unroll
        for (int i = 0; i < 4; ++i) {
            const int c = (i * 64 + lane) * 8; float hv[8];
#pragma unroll
            for (int hh = 0; hh < 2; ++hh) { const f32x4 s4 = *(const f32x4*)(sh + c + hh * 4), c4 = *(const f32x4*)(sc + c + hh * 4), g4 = *(const f32x4*)(g + c + hh * 4);
#pragma unroll
                for (int j = 0; j < 4; ++j) hv[hh * 4 + j] = xv[i * 8 + hh * 4 + j] * rinv * g4[j] * (c4[j] + 1.0f) + s4[j]; }
            u32x4 w; w.x = cvt_pk_bf16(hv[0], hv[1]); w.y = cvt_pk_bf16(hv[2], hv[3]); w.z = cvt_pk_bf16(hv[4], hv[5]); w.w = cvt_pk_bf16(hv[6], hv[7]);
            *(u32x4*)(HX + (size_t)row * 2048 + c) = w;
        }
    }
}

constexpr int SC_QS = 0, SC_KS = 17408, SC_VT = 34816, SC_VW = 41984, SC_SET = 49152  , SC_P = 98304, SC_CT = 107520, SC_GA = 120576, SC_SC = 157440;
constexpr int QSTR = 272, TSTR = 144, VSTR = 112, NPOS = 2304;
typedef short v4s __attribute__((ext_vector_type(4)));
__device__ __forceinline__ bf16x8 tr_read8(LAS unsigned char* base, int S, int c, int ks, int lane) {
    const int g = lane >> 4, q = (lane >> 2) & 3, pp = lane & 3;
    LAS unsigned char* a0 = base + (32 * ks + 8 * g + q) * S + 32 * c + 8 * pp;
    const v4s lo = __builtin_amdgcn_ds_read_tr16_b64_v4i16((LAS v4s*)a0);
    const v4s hi = __builtin_amdgcn_ds_read_tr16_b64_v4i16((LAS v4s*)(a0 + 4 * S));
    return (bf16x8){lo[0], lo[1], lo[2], lo[3], hi[0], hi[1], hi[2], hi[3]};
}
__device__ __forceinline__ void phase_scan(const Params& p, int l, LAS unsigned char* lds) {
    int tid_ = threadIdx.x; asm volatile("" : "+v"(tid_));
    const int tid = tid_, wid = tid >> 6, lane = tid & 63, fr = lane & 15, fq = lane >> 4;
    const bf16_t* Qg = (const bf16_t*)(p.ws + OFF_Q); const bf16_t* Kg = (const bf16_t*)(p.ws + OFF_K); const bf16_t* Vg = (const bf16_t*)(p.ws + OFF_V);
    const float* Gg = (const float*)(p.ws + OFF_G);
    LAS float* RB = (LAS float*)(lds + SC_GA); LAS float* CS = RB + NPOS; LAS float* EM = CS + NPOS; LAS float* WS = EM + NPOS;
    LAS float* BL = (LAS float*)(lds + SC_SC); LAS float* MG = BL + 36; LAS float* MST = MG + 36; LAS float* MNEW = MST + 36; LAS float* AA = MNEW + 36;
    const bool wr_ctx = l < DEPTH - 1;
    for (int item = blockIdx.x; item < 256; item += gridDim.x) {
        const int xcd = item & 7, idx = item >> 3, bh = xcd * 4 + (idx >> 3), sub = idx & 7, dir = sub >> 2, es = sub & 3, b = bh >> 3, h = bh & 7;
        const int flip = dir ? 63 : 0;
        bf16_t* Hg = (bf16_t*)(p.ws + (dir ? OFF_HB : OFF_HF));
        __syncthreads();
        {
            const float bi_ = p.b_gate[l * 32 + dir * 16 + h], bf_ = p.b_gate[l * 32 + dir * 16 + 8 + h];
            for (int j = wid; j < 36; j += 8) {
                int rb; if (j < 4) { const int oc = dir ? 3 - j : j; rb = MLAT + b * CTXL + oc * 64; } else { const int jl = j - 4, oc = dir ? 31 - jl : jl; rb = b * SEQL + oc * 64; }
                const int row = rb + (lane ^ flip);
                const float gi = Gg[(size_t)(dir * 16 + h) * MTOT + row] + bi_;
                const float gf = Gg[(size_t)(dir * 16 + 8 + h) * MTOT + row] + bf_;
                const float lf = fminf(gf, 0.f) - log1pf(__expf(-fabsf(gf)));
                float bs = lf;
#pragma unroll
                for (int o = 1; o < 64; o <<= 1) { const float t = bperm(bs, (lane - o) & 63); if (lane >= o) bs += t; }
                const float cs = gi - bs;
                float pm = cs;
#pragma unroll
                for (int o = 1; o < 64; o <<= 1) { const float t = bperm(pm, (lane - o) & 63); if (lane >= o) pm = fmaxf(pm, t); }
                const int pi = j * 64 + lane;
                RB[pi] = bs; CS[pi] = cs; EM[pi] = pm;
                const float bl = bperm(bs, 63), pml = bperm(pm, 63);
                if (lane == 0) { BL[j] = bl; MG[j] = bl + pml; }
            }
            __syncthreads();
            if (tid == 0) { float m = NEGV; for (int j = 0; j < 36; ++j) { MST[j] = m; const float mn = fmaxf(BL[j] + m, MG[j]); MNEW[j] = mn; AA[j] = __expf(BL[j] + m - mn); m = mn; } }
            __syncthreads();
            for (int pi = tid; pi < NPOS; pi += 512) {
                const int j = pi >> 6; const float B = RB[pi], pm = EM[pi], cs = CS[pi], mst = MST[j];
                const float mt = B + fmaxf(mst, pm);
                RB[pi] = B - mt; EM[pi] = __expf(-mt); WS[pi] = __expf(BL[j] + cs - MNEW[j]);
            }
            if (tid < 128) { const int s = tid >> 1, hf = tid & 1; unsigned z0 = 0u; asm volatile("" : "+v"(z0)); const u32x4 one = (u32x4){z0 + 0x3F80u, z0, z0, z0}, zz = (u32x4){z0, z0, z0, z0};
                *(LAS u32x4*)(lds + SC_VT + s * VSTR + 64 + hf * 16) = hf ? zz : one; *(LAS u32x4*)(lds + SC_VW + s * VSTR + 64 + hf * 16) = zz;
                *(LAS u32x4*)(lds + SC_SET + SC_VT + s * VSTR + 64 + hf * 16) = hf ? zz : one; *(LAS u32x4*)(lds + SC_SET + SC_VW + s * VSTR + 64 + hf * 16) = zz; }
            __syncthreads();
        }
        f32x4 st[3];
#pragma unroll
        for (int n = 0; n < 3; ++n) st[n] = zero4();
        u32x4 rqA[2], rkA[2], rvA, rqB[2], rkB[2], rvB;
        { unsigned z0 = 0u; asm volatile("" : "+v"(z0)); rvA = (u32x4){z0, z0, z0, z0}; rvB = rvA; }
#define SCAN_ROWBASE(j, rbv) do { if ((j) < 4) { const int oc_ = dir ? 3 - (j) : (j); rbv = MLAT + b * CTXL + oc_ * 64; } else { const int jl_ = (j) - 4, oc_ = dir ? 31 - jl_ : jl_; rbv = b * SEQL + oc_ * 64; } } while (0)
#define SCAN_LOAD(j, rq, rk, rv) do { int rb_; SCAN_ROWBASE(j, rb_); \
        _Pragma("unroll") for (int i = 0; i < 2; ++i) { const int ix = tid + i * 512; rq[i] = *(const u32x4*)(Qg + (size_t)(rb_ + (ix >> 4)) * 1024 + h * 128 + (ix & 15) * 8); \
                                                         rk[i] = *(const u32x4*)(Kg + (size_t)(rb_ + (ix >> 4)) * 1024 + h * 128 + (ix & 15) * 8); } \
        if (tid < 256) rv = *(const u32x4*)(Vg + (size_t)(rb_ + (tid >> 2)) * 1024 + h * 128 + es * 32 + (tid & 3) * 8); } while (0)
#define SCAN_WRITE(j, rq, rk, rv, WB) do { \
        _Pragma("unroll") for (int i = 0; i < 2; ++i) { const int ix = tid + i * 512; *(LAS u32x4*)(lds + (WB) + SC_QS + (ix >> 4) * QSTR + (ix & 15) * 16) = rq[i]; *(LAS u32x4*)(lds + (WB) + SC_KS + (ix >> 4) * QSTR + (ix & 15) * 16) = rk[i]; } \
        if (tid < 256) { const int s_ = tid >> 2; const float ws_ = WS[(j) * 64 + (s_ ^ flip)]; *(LAS u32x4*)(lds + (WB) + SC_VT + s_ * VSTR + (tid & 3) * 16) = rv; \
            u32x4 vw_; vw_.x = cvt_pk_bf16(bflo(rv.x) * ws_, bfhi(rv.x) * ws_); vw_.y = cvt_pk_bf16(bflo(rv.y) * ws_, bfhi(rv.y) * ws_); \
            vw_.z = cvt_pk_bf16(bflo(rv.z) * ws_, bfhi(rv.z) * ws_); vw_.w = cvt_pk_bf16(bflo(rv.w) * ws_, bfhi(rv.w) * ws_); *(LAS u32x4*)(lds + (WB) + SC_VW + s_ * VSTR + (tid & 3) * 16) = vw_; } \
        else if (tid < 320) { const float ws_ = WS[(j) * 64 + (lane ^ flip)]; unsigned z0 = 0u; asm volatile("" : "+v"(z0)); *(LAS u32x4*)(lds + (WB) + SC_VW + lane * VSTR + 64) = (u32x4){cvt_pk_bf16(ws_, 0.f), z0, z0, z0}; } } while (0)
#define SCAN_STEP(jv, LQ, LK, LV, WQ, WK, WV, RBASE, WBASE) do { const int j = (jv); \
            if (j + 2 < 36) SCAN_LOAD(j + 2, LQ, LK, LV); \
            const int g0 = j * 64; \
            const int mt_ = wid & 3, nr = wid >> 2; \
            bf16x8 qf[4]; \
            { \
                const int ms0 = (wid >> 2) * 2; \
                f32x4 sa[2]; sa[0] = zero4(); sa[1] = sa[0]; \
_Pragma("unroll") \
                for (int kk = 0; kk < 4; ++kk) { \
                    qf[kk] = *(const LAS bf16x8*)(lds + (RBASE) + SC_QS + (mt_ * 16 + fr) * QSTR + kk * 64 + fq * 16); \
_Pragma("unroll") \
                    for (int i = 0; i < 2; ++i) { const bf16x8 ak = *(const LAS bf16x8*)(lds + (RBASE) + SC_KS + ((ms0 + i) * 16 + fr) * QSTR + kk * 64 + fq * 16); sa[i] = __builtin_amdgcn_mfma_f32_16x16x32_bf16(ak, qf[kk], sa[i], 0, 0, 0); } \
                } \
                const int t = mt_ * 16 + fr, tp = t ^ flip; const float rbt = RB[g0 + tp]; \
_Pragma("unroll") \
                for (int i = 0; i < 2; ++i) { \
                    const int s0 = (ms0 + i) * 16 + fq * 4; float pv[4]; \
_Pragma("unroll") \
                    for (int jj = 0; jj < 4; ++jj) { const int sp = (s0 + jj) ^ flip; pv[jj] = (sp <= tp) ? sa[i][jj] * __expf(rbt + CS[g0 + sp]) : 0.f; } \
                    u32x2 w; w.x = cvt_pk_bf16(pv[0], pv[1]); w.y = cvt_pk_bf16(pv[2], pv[3]); \
                    *(LAS u32x2*)(lds + SC_P + t * TSTR + s0 * 2) = w; \
                } \
_Pragma("unroll") \
                for (int n = 0; n < 3; ++n) { u32x2 w; w.x = cvt_pk_bf16(st[n][0], st[n][1]); w.y = cvt_pk_bf16(st[n][2], st[n][3]); *(LAS u32x2*)(lds + SC_CT + (n * 16 + fr) * QSTR + (wid * 16 + fq * 4) * 2) = w; } \
            } \
            if (j + 1 < 36) { SCAN_WRITE(j + 1, WQ, WK, WV, WBASE); } \
            __syncthreads(); \
            { \
                f32x4 ar = zero4(), aa = ar; \
_Pragma("unroll") \
                for (int kk = 0; kk < 4; ++kk) { \
                    const bf16x8 br = *(const LAS bf16x8*)(lds + SC_CT + (nr * 16 + fr) * QSTR + kk * 64 + fq * 16); \
                    const bf16x8 ba = *(const LAS bf16x8*)(lds + SC_CT + (32 + fr) * QSTR + kk * 64 + fq * 16); \
                    ar = __builtin_amdgcn_mfma_f32_16x16x32_bf16(qf[kk], br, ar, 0, 0, 0); aa = __builtin_amdgcn_mfma_f32_16x16x32_bf16(qf[kk], ba, aa, 0, 0, 0); \
                } \
                const int t0 = mt_ * 16 + fq * 4; \
_Pragma("unroll") \
                for (int jj = 0; jj < 4; ++jj) { const float wi = __expf(RB[g0 + ((t0 + jj) ^ flip)] + MST[j]); ar[jj] *= wi; aa[jj] *= wi; } \
_Pragma("unroll") \
                for (int kk = 0; kk < 2; ++kk) { \
                    const bf16x8 ap = *(const LAS bf16x8*)(lds + SC_P + (mt_ * 16 + fr) * TSTR + kk * 64 + fq * 16); \
                    const bf16x8 br = tr_read8(lds + (RBASE) + SC_VT, VSTR, nr, kk, lane); \
                    const bf16x8 ba = tr_read8(lds + (RBASE) + SC_VT, VSTR, 2, kk, lane); \
                    ar = __builtin_amdgcn_mfma_f32_16x16x32_bf16(ap, br, ar, 0, 0, 0); aa = __builtin_amdgcn_mfma_f32_16x16x32_bf16(ap, ba, aa, 0, 0, 0); \
                } \
                int rb_; SCAN_ROWBASE(j, rb_); \
                const bool do_wr = (j >= 4) || wr_ctx; \
_Pragma("unroll") \
                for (int jj = 0; jj < 4; ++jj) { \
                    const float den = bperm(aa[jj], lane & 48); const float em = EM[g0 + ((t0 + jj) ^ flip)]; \
                    const float hv = ar[jj] / fmaxf(fabsf(den), em); \
                    const float hn = bperm(hv, lane ^ 1); \
                    if (do_wr && !(fr & 1)) *(unsigned*)(Hg + (size_t)(rb_ + t0 + jj) * 1024 + h * 128 + es * 32 + nr * 16 + fr) = cvt_pk_bf16(hv, hn); \
                } \
                const float aj = AA[j]; \
_Pragma("unroll") \
                for (int n = 0; n < 3; ++n) st[n] *= aj; \
_Pragma("unroll") \
                for (int kk = 0; kk < 2; ++kk) { \
                    const bf16x8 ak = tr_read8(lds + (RBASE) + SC_KS, QSTR, wid, kk, lane); \
_Pragma("unroll") \
                    for (int n = 0; n < 3; ++n) { const bf16x8 bv = tr_read8(lds + (RBASE) + SC_VW, VSTR, n, kk, lane); st[n] = __builtin_amdgcn_mfma_f32_16x16x32_bf16(ak, bv, st[n], 0, 0, 0); } \
                } \
            } \
            __syncthreads(); \
        } while (0)
        SCAN_LOAD(0, rqA, rkA, rvA);
        SCAN_WRITE(0, rqA, rkA, rvA, 0);
        __syncthreads();
        SCAN_LOAD(1, rqA, rkA, rvA);
        for (int j2 = 0; j2 < 36; j2 += 2) {
            SCAN_STEP(j2, rqB, rkB, rvB, rqA, rkA, rvA, 0, SC_SET);
            SCAN_STEP(j2 + 1, rqA, rkA, rvA, rqB, rkB, rvB, SC_SET, 0);
        }
#undef SCAN_STEP
#undef SCAN_ROWBASE
#undef SCAN_LOAD
#undef SCAN_WRITE
    }
}

__device__ __forceinline__ void phase_conv(const Params& p, int l, LAS unsigned char* lds) {
    int tid_ = threadIdx.x; asm volatile("" : "+v"(tid_));
    const int tid = tid_, lane = tid & 63, gw = blockIdx.x * 8 + (tid >> 6), nw = gridDim.x * 8;
    LAS float* wd = (LAS float*)lds;
    __syncthreads();
    for (int i = tid; i < 31 * 256; i += 512) *(LAS f32x4*)(wd + i * 4) = *(const f32x4*)(p.w_dw + (size_t)l * 31 * 1024 + i * 4);
    for (int i = tid; i < 256; i += 512) *(LAS f32x4*)(wd + 31 * 1024 + i * 4) = zero4();
    __syncthreads();
    const bf16_t* __restrict__ U = (const bf16_t*)(p.ws + OFF_U); bf16_t* __restrict__ UC = (bf16_t*)(p.ws + OFF_UC);
    const int cH = lane * 8, cV = 512 + lane * 8;
    const int nrows = l < DEPTH - 1 ? MTOT : MLAT;
    for (int row = gw; row < nrows; row += nw) {
        float acc[16];
        int zl = 0; asm volatile("" : "+v"(zl));
        { const f32x4 b0 = *(const f32x4*)(p.b_dw + l * 1024 + cH + zl), b1 = *(const f32x4*)(p.b_dw + l * 1024 + cH + 4 + zl), b2 = *(const f32x4*)(p.b_dw + l * 1024 + cV + zl), b3 = *(const f32x4*)(p.b_dw + l * 1024 + cV + 4 + zl);
#pragma unroll
          for (int i = 0; i < 4; ++i) { acc[i] = b0[i]; acc[4 + i] = b1[i]; acc[8 + i] = b2[i]; acc[12 + i] = b3[i]; } }
        const bool lat = row < MLAT;
        const int n = lat ? (row & 2047) : ((row - MLAT) & 255);
        const int posH = lat ? (n & 63) : n, limH = lat ? 64 : 256;
        const int posV = lat ? (n >> 6) : n, limV = lat ? 32 : 256, strV = lat ? 64 : 1;
#pragma unroll 1
        for (int jb = 0; jb < 32; jb += 8) {
            u32x4 uH[8], uV[8]; int wH[8], wV[8];
#pragma unroll
            for (int jj = 0; jj < 8; ++jj) {
                const int j = jb + jj, dj = j - 15;
                const bool okH = (j < 31) && ((unsigned)(posH + dj) < (unsigned)limH), okV = (j < 31) && ((unsigned)(posV + dj) < (unsigned)limV);
                const int rH = okH ? row + dj : row, rV = okV ? row + dj * strV : row;
                wH[jj] = (okH ? j : 31) * 1024; wV[jj] = (okV ? j : 31) * 1024;
                uH[jj] = *(const u32x4*)(U + (size_t)rH * 1024 + cH);
                uV[jj] = *(const u32x4*)(U + (size_t)rV * 1024 + cV);
            }
#pragma unroll
            for (int jj = 0; jj < 8; ++jj) {
                { const u32x4 uv = uH[jj]; const f32x4 w0 = *(const LAS f32x4*)(wd + wH[jj] + cH), w1 = *(const LAS f32x4*)(wd + wH[jj] + cH + 4);
                  acc[0] += bflo(uv.x) * w0[0]; acc[1] += bfhi(uv.x) * w0[1]; acc[2] += bflo(uv.y) * w0[2]; acc[3] += bfhi(uv.y) * w0[3];
                  acc[4] += bflo(uv.z) * w1[0]; acc[5] += bfhi(uv.z) * w1[1]; acc[6] += bflo(uv.w) * w1[2]; acc[7] += bfhi(uv.w) * w1[3]; }
                { const u32x4 uv = uV[jj]; const f32x4 w0 = *(const LAS f32x4*)(wd + wV[jj] + cV), w1 = *(const LAS f32x4*)(wd + wV[jj] + cV + 4);
                  acc[8] += bflo(uv.x) * w0[0]; acc[9] += bfhi(uv.x) * w0[1]; acc[10] += bflo(uv.y) * w0[2]; acc[11] += bfhi(uv.y) * w0[3];
                  acc[12] += bflo(uv.z) * w1[0]; acc[13] += bfhi(uv.z) * w1[1]; acc[14] += bflo(uv.w) * w1[2]; acc[15] += bfhi(uv.w) * w1[3]; }
            }
        }
        float s = 0.f;
#pragma unroll
        for (int i = 0; i < 16; ++i) s += acc[i];
        const float mean = wave_sum(s, lane) * (1.0f / 1024.0f);
        float q = 0.f;
#pragma unroll
        for (int i = 0; i < 16; ++i) { acc[i] -= mean; q += acc[i] * acc[i]; }
        const float rstd = rsqrtf(wave_sum(q, lane) * (1.0f / 1024.0f) + EPS);
        float y[16];
        asm volatile("" : "+v"(zl));
#pragma unroll
        for (int hh = 0; hh < 4; ++hh) {
            const int cb = (hh < 2 ? cH : cV) + (hh & 1) * 4;
            const f32x4 g4 = *(const f32x4*)(p.ln_g + l * 1024 + cb + zl), b4 = *(const f32x4*)(p.ln_b + l * 1024 + cb + zl);
#pragma unroll
            for (int i = 0; i < 4; ++i) y[hh * 4 + i] = siluf_(acc[hh * 4 + i] * rstd * g4[i] + b4[i]);
        }
        u32x4 w; w.x = cvt_pk_bf16(y[0], y[1]); w.y = cvt_pk_bf16(y[2], y[3]); w.z = cvt_pk_bf16(y[4], y[5]); w.w = cvt_pk_bf16(y[6], y[7]);
        *(u32x4*)(UC + (size_t)row * 1024 + cH) = w;
        w.x = cvt_pk_bf16(y[8], y[9]); w.y = cvt_pk_bf16(y[10], y[11]); w.z = cvt_pk_bf16(y[12], y[13]); w.w = cvt_pk_bf16(y[14], y[15]);
        *(u32x4*)(UC + (size_t)row * 1024 + cV) = w;
    }
}

__device__ __forceinline__ void phase_mout(const Params& p, int l, int sid, int nside) {
    int tid_ = threadIdx.x; asm volatile("" : "+v"(tid_));
    const int lane = tid_ & 63, gw = sid * 8 + (tid_ >> 6), nw = nside * 8;
    const bf16_t* HF = (const bf16_t*)(p.ws + OFF_HF); const bf16_t* HB = (const bf16_t*)(p.ws + OFF_HB);
    const bf16_t* OG = (const bf16_t*)(p.ws + OFF_OG); bf16_t* CAT = (bf16_t*)(p.ws + OFF_CAT);
    const int nrows = l < DEPTH - 1 ? MTOT : MLAT;
    const int c0 = lane * 16;
    for (int row = gw; row < nrows; row += nw) {
        float hv[16]; float s = 0.f;
#pragma unroll
        for (int i = 0; i < 2; ++i) {
            const u32x4 a = *(const u32x4*)(HF + (size_t)row * 1024 + c0 + i * 8), bb = *(const u32x4*)(HB + (size_t)row * 1024 + c0 + i * 8);
            hv[i * 8 + 0] = bflo(a.x) + bflo(bb.x); hv[i * 8 + 1] = bfhi(a.x) + bfhi(bb.x); hv[i * 8 + 2] = bflo(a.y) + bflo(bb.y); hv[i * 8 + 3] = bfhi(a.y) + bfhi(bb.y);
            hv[i * 8 + 4] = bflo(a.z) + bflo(bb.z); hv[i * 8 + 5] = bfhi(a.z) + bfhi(bb.z); hv[i * 8 + 6] = bflo(a.w) + bflo(bb.w); hv[i * 8 + 7] = bfhi(a.w) + bfhi(bb.w);
        }
#pragma unroll
        for (int i = 0; i < 16; ++i) s += hv[i];
        s += bperm(s, lane ^ 1); s += bperm(s, lane ^ 2); s += bperm(s, lane ^ 4);
        const float mean = s * (1.0f / 128.0f); float q = 0.f;
#pragma unroll
        for (int i = 0; i < 16; ++i) { hv[i] -= mean; q += hv[i] * hv[i]; }
        q += bperm(q, lane ^ 1); q += bperm(q, lane ^ 2); q += bperm(q, lane ^ 4);
        const float rstd = rsqrtf(q * (1.0f / 128.0f) + EPS);
        const u32x4 og0 = *(const u32x4*)(OG + (size_t)row * 1024 + c0), og1 = *(const u32x4*)(OG + (size_t)row * 1024 + c0 + 8);
        const unsigned ogw[8] = {og0.x, og0.y, og0.z, og0.w, og1.x, og1.y, og1.z, og1.w};
        unsigned ow[8];
#pragma unroll
        for (int i = 0; i < 8; ++i) {
            const float g0 = p.g_head[l * 1024 + c0 + 2 * i], g1 = p.g_head[l * 1024 + c0 + 2 * i + 1];
            ow[i] = cvt_pk_bf16(hv[2 * i] * rstd * g0 * bflo(ogw[i]), hv[2 * i + 1] * rstd * g1 * bfhi(ogw[i]));
        }
        *(u32x4*)(CAT + (size_t)row * 2048 + 1024 + c0) = (u32x4){ow[0], ow[1], ow[2], ow[3]};
        *(u32x4*)(CAT + (size_t)row * 2048 + 1024 + c0 + 8) = (u32x4){ow[4], ow[5], ow[6], ow[7]};
    }
}

__global__ void __launch_bounds__(512, 2) fwd_mega(const float* __restrict__ a0, const float* __restrict__ a1, const float* __restrict__ a2, const float* __restrict__ a3,
        const float* __restrict__ a4, const float* __restrict__ a5, const float* __restrict__ a6, const float* __restrict__ a7, const float* __restrict__ a8,
        const float* __restrict__ a9, const float* __restrict__ a10, const float* __restrict__ a11, const float* __restrict__ a12, const float* __restrict__ a13,
        const float* __restrict__ a14, const float* __restrict__ a15, const float* __restrict__ a16, float* outp, unsigned char* wsp, int ph_lo, int ph_hi, int pmode) {
    Params p; p.x = a0; p.c = a1; p.ctx = a2; p.c_ctx = a3; p.w_ada = a4; p.b_ada = a5; p.g_pre = a6; p.g_post = a7; p.w_in = a8; p.b_gate = a9; p.w_dw = a10; p.b_dw = a11;
    p.ln_g = a12; p.ln_b = a13; p.w_pw2 = a14; p.g_head = a15; p.w_out = a16; p.out = outp; p.ws = wsp; p.ph_lo = ph_lo; p.ph_hi = ph_hi;
    extern __shared__ __attribute__((aligned(16))) unsigned char shm[];
    LAS unsigned char* lds = (LAS unsigned char*)shm;
    cg::grid_group grid = cg::this_grid();
    volatile LAS unsigned* xst = (volatile LAS unsigned*)(lds + LDS_BYTES - 16);
    if (threadIdx.x == 0) { xst[0] = 0u; xst[1] = 0u; }
    __syncthreads();
    const XcdBarrier xbar = xcd_barrier_post((unsigned*)(wsp + OFF_BAR), xst);
    if (ph_hi > 1000) grid.sync();
#define GRID_SYNC() xcd_barrier(xbar)
    for (int ph = p.ph_lo; ph < p.ph_hi; ++ph) {
        size_t zoff = 0; asm volatile("" : "+s"(zoff)); unsigned char* ws = p.ws + zoff;
        const int G = (int)gridDim.x, bid = (int)blockIdx.x;
        int tasks = 0, l_ada = 0, l_w = 0, sid = bid, nside = G;
        if (ph == 0) { tasks = 1 | 2; }
        else if (ph == 1) phase_norm(p, -1, 0);
        else if (ph >= 100) { }
        else {
            const int l = (ph - 2) / 5, s = (ph - 2) % 5;
            if (s == 0) {
                EpiIn E; E.ws = ws;
                gemm_phase<EpiIn>(lds, (const bf16_t*)(ws + OFF_HX), (const bf16_t*)(ws + OFF_WIN) + (size_t)l * NINP * 2048, MTOT, NINP, 2048, E);
                const int nun = (MTOT / 256) * (NINP / 256), first_idle = nun % G;
                tasks = 4; l_w = l;
                if (first_idle != 0) { if (bid >= first_idle) { sid = bid - first_idle; nside = G - first_idle; } else tasks = 0; }
            } else if (s == 1) {
                if (pmode != 2) phase_scan(p, l, lds);
                if (pmode != 1) phase_conv(p, l, lds);
            } else if (s == 2) {
                const int Mr = l < DEPTH - 1 ? MTOT : MLAT;
                EpiPw E; E.ws = ws;
                gemm_phase<EpiPw>(lds, (const bf16_t*)(ws + OFF_UC), (const bf16_t*)(ws + OFF_WPW) + (size_t)l * 1024 * 1024, Mr, 1024, 1024, E);
                const int nun = (Mr / 256) * 4;
                if (nun < G) { if (bid >= nun) phase_mout(p, l, bid - nun, G - nun); } else phase_mout(p, l, bid, G);
            } else if (s == 3) {
                const int Mr = l < DEPTH - 1 ? MTOT : MLAT;
                EpiOut E; E.ws = ws;
                gemm_phase<EpiOut>(lds, (const bf16_t*)(ws + OFF_CAT), (const bf16_t*)(ws + OFF_WOUT) + (size_t)l * 2048 * 2048, Mr, 2048, 2048, E);
                if (l < DEPTH - 1) {
                    const int nun = (Mr / 256) * 8, first_idle = nun % G;
                    tasks = 2 | 1; l_w = l + 1; l_ada = l + 1;
                    if (first_idle != 0) { if (bid >= first_idle) { sid = bid - first_idle; nside = G - first_idle; } else tasks = 0; }
                }
            } else {
                phase_norm(p, l, l < DEPTH - 1 ? l + 1 : -1, p.ph_hi - p.ph_lo == 1);
            }
        }
        if (tasks) side_work(p, lds, tasks, l_ada, l_w, sid, nside);
        if (ph + 1 < p.ph_hi) GRID_SYNC();
    }
}

extern "C" void kernel_launch(void* const* d_in, const int* in_sizes, int n_in, void* d_out, int out_size, void* d_ws, size_t ws_size, hipStream_t stream) {
    static int grid_blocks = 0;
    if (grid_blocks == 0) {
        if (n_in != 17 || ws_size < WS_END) { fprintf(stderr, "kernel_launch: unexpected n_in %d or ws_size %zu (need %zu)\n", n_in, ws_size, (size_t)WS_END); grid_blocks = -1; return; }
        int dev = 0, cus = 0, per_cu = 0;
        (void)hipGetDevice(&dev);
        (void)hipDeviceGetAttribute(&cus, hipDeviceAttributeMultiprocessorCount, dev);
        if (hipFuncSetAttribute((const void*)fwd_mega, hipFuncAttributeMaxDynamicSharedMemorySize, LDS_BYTES) != hipSuccess) { fprintf(stderr, "kernel_launch: hipFuncSetAttribute failed\n"); grid_blocks = -1; return; }
        if (hipOccupancyMaxActiveBlocksPerMultiprocessor(&per_cu, (const void*)fwd_mega, 512, LDS_BYTES) != hipSuccess || per_cu < 1) { fprintf(stderr, "kernel_launch: occupancy query says %d\n", per_cu); per_cu = 1; (void)hipGetLastError(); }
        grid_blocks = cus * 1;
        if (grid_blocks <= 0) grid_blocks = 256;
    }
    if (grid_blocks < 0) return;
    Params p{};
    p.x = (const float*)d_in[0]; p.c = (const float*)d_in[1]; p.ctx = (const float*)d_in[2]; p.c_ctx = (const float*)d_in[3];
    p.w_ada = (const float*)d_in[4]; p.b_ada = (const float*)d_in[5]; p.g_pre = (const float*)d_in[6]; p.g_post = (const float*)d_in[7];
    p.w_in = (const float*)d_in[8]; p.b_gate = (const float*)d_in[9]; p.w_dw = (const float*)d_in[10]; p.b_dw = (const float*)d_in[11];
    p.ln_g = (const float*)d_in[12]; p.ln_b = (const float*)d_in[13]; p.w_pw2 = (const float*)d_in[14]; p.g_head = (const float*)d_in[15]; p.w_out = (const float*)d_in[16];
    p.out = (float*)d_out; p.ws = (unsigned char*)d_ws;
    p.ph_lo = 0; p.ph_hi = 2 + 5 * DEPTH;
    if (hipMemsetAsync((char*)d_ws + OFF_BAR, 0, 16384, stream) != hipSuccess) { fprintf(stderr, "kernel_launch: memset of barrier words failed\n"); return; }
    int pmode = 0;
    void* args[] = {&p.x, &p.c, &p.ctx, &p.c_ctx, &p.w_ada, &p.b_ada, &p.g_pre, &p.g_post, &p.w_in, &p.b_gate, &p.w_dw, &p.b_dw, &p.ln_g, &p.ln_b, &p.w_pw2, &p.g_head, &p.w_out, &p.out, &p.ws, &p.ph_lo, &p.ph_hi, &pmode};
    hipError_t e = hipLaunchCooperativeKernel((const void*)fwd_mega, dim3(grid_blocks), dim3(512), args, LDS_BYTES, stream);
    if (e != hipSuccess) fprintf(stderr, "cooperative launch failed: %s (grid %d)\n", hipGetErrorString(e), grid_blocks);
#if PROBE_PH >= 0
    for (int r = 0; r < PROBE_REPS; ++r) {
        p.ph_lo = PROBE_PH % 1000; p.ph_hi = p.ph_lo + 1; pmode = PROBE_PH / 1000;
        (void)hipMemsetAsync((char*)d_ws + OFF_BAR, 0, 16384, stream);
        (void)hipLaunchCooperativeKernel((const void*)fwd_mega, dim3(grid_blocks), dim3(512), args, LDS_BYTES, stream);
    }
#endif
}
```

```cpp
#include <hip/hip_runtime.h>
#include <hip/hip_cooperative_groups.h>
#include <cstdio>
namespace cg = cooperative_groups;

#define LAS __attribute__((address_space(3)))
typedef unsigned short bf16_t;
typedef short bf16x8 __attribute__((ext_vector_type(8)));
typedef float f32x4 __attribute__((ext_vector_type(4)));
typedef unsigned u32x4 __attribute__((ext_vector_type(4)));
typedef unsigned u32x2 __attribute__((ext_vector_type(2)));

constexpr int DM = 2048, SEQL = 2048, DEPTH = 4, CTXL = 256;
constexpr int MLAT = 8192, MTOT = 9216, WCV = 1024, NIN = 8224, NINP = 8448;
constexpr float EPS = 1e-6f, NEGV = -1e30f;
constexpr int LDS_BYTES = 163840;
#ifndef PROBE_PH
#define PROBE_PH -1
#define PROBE_REPS 0
#endif

constexpr size_t SZ_WIN = (size_t)DEPTH * NINP * DM * 2, SZ_WOUT = (size_t)DEPTH * DM * DM * 2, SZ_WPW = (size_t)DEPTH * WCV * WCV * 2;
constexpr size_t SZ_ADA = (size_t)DEPTH * 5 * 6144 * 4, SZ_T2K = (size_t)MTOT * 2048 * 2, SZ_T1K = (size_t)MTOT * 1024 * 2;
constexpr size_t SZ_G = (size_t)MTOT * 32 * 4, SZ_H = (size_t)MTOT * 1024 * 4, SZ_F2K = (size_t)MTOT * 2048 * 4;
constexpr size_t OFF_WIN = 0, OFF_WOUT = OFF_WIN + SZ_WIN, OFF_WPW = OFF_WOUT + SZ_WOUT, OFF_ADA = OFF_WPW + SZ_WPW;
constexpr size_t OFF_HX = OFF_ADA + SZ_ADA, OFF_U = OFF_HX + SZ_T2K, OFF_Z = OFF_U + SZ_T1K, OFF_Q = OFF_Z + SZ_T1K, OFF_K = OFF_Q + SZ_T1K;
constexpr size_t OFF_V = OFF_K + SZ_T1K, OFF_OG = OFF_V + SZ_T1K, OFF_UC = OFF_OG + SZ_T1K, OFF_G = OFF_UC + SZ_T1K;
constexpr size_t OFF_HF = OFF_G + SZ_G, OFF_HB = OFF_HF + SZ_H, OFF_CAT = OFF_HB + SZ_H, OFF_OUT = OFF_CAT + SZ_T2K, OFF_XW = OFF_OUT + SZ_F2K;
constexpr size_t OFF_BAR = OFF_XW + SZ_F2K;
constexpr size_t WS_END = OFF_BAR + 16384;

struct Params {
    const float *x, *c, *ctx, *c_ctx, *w_ada, *b_ada, *g_pre, *g_post, *w_in, *b_gate, *w_dw, *b_dw, *ln_g, *ln_b, *w_pw2, *g_head, *w_out;
    float* out; unsigned char* ws;
    int ph_lo, ph_hi;
};

__device__ __forceinline__ unsigned cvt_pk_bf16(float lo, float hi) { unsigned r; asm("v_cvt_pk_bf16_f32 %0, %1, %2" : "=v"(r) : "v"(lo), "v"(hi)); return r; }
__device__ __forceinline__ f32x4 zero4() { float z = 0.f; asm volatile("" : "+v"(z)); return (f32x4){z, z, z, z}; }
__device__ __forceinline__ float bflo(unsigned w) { return __uint_as_float(w << 16); }
__device__ __forceinline__ float bfhi(unsigned w) { return __uint_as_float(w & 0xffff0000u); }
__device__ __forceinline__ float sigmoidf_(float x) { return __builtin_amdgcn_rcpf(1.0f + __expf(-x)); }
__device__ __forceinline__ float siluf_(float x) { return x * sigmoidf_(x); }
__device__ __forceinline__ float bperm(float v, int srclane) { return __int_as_float(__builtin_amdgcn_ds_bpermute(srclane << 2, __float_as_int(v))); }
__device__ __forceinline__ float wave_sum(float v, int lane) {
#pragma unroll
    for (int o = 32; o >= 1; o >>= 1) v += bperm(v, lane ^ o);
    return v;
}
__host__ __device__ __forceinline__ int perm32(int rho) { const int n = rho >> 4, i = rho & 15; return 8 * (i >> 2) + 4 * n + (i & 3); }
__device__ __forceinline__ int colmap_in(int np) {
    const int pn = np >> 8, within = np & 255, bj = within >> 7, w32 = (within >> 5) & 3, rho = within & 31;
    const int lc = w32 * 32 + perm32(rho);
    if (pn < 8) return (bj ? 1024 : 0) + pn * 128 + lc;
    if (pn < 24) return 2048 + (pn - 8) * 256 + w32 * 64 + bj * 32 + perm32(rho);
    if (pn < 32) return (bj ? 7168 : 6144) + (pn - 24) * 128 + lc;
    return within < 32 ? 8192 + within : -1;
}


#define XB_TMO      128
#define XB_XCNT(j)  (256  + 64 * (j))
#define XB_XSUB(j)  (1280 + 64 * (j))
#define XB_XGEN(j)  (2304 + 64 * (j))
#define XB_TOP      3328
#define XB_TOPGEN   3392
#define XCD_BAR_WORDS 3456
#define XB_SPIN_CAP (1u << 18)
__device__ __forceinline__ unsigned xb_ld(unsigned* p)              { return __hip_atomic_load(p, __ATOMIC_RELAXED, __HIP_MEMORY_SCOPE_AGENT); }
__device__ __forceinline__ unsigned xb_add(unsigned* p, unsigned v) { return __hip_atomic_fetch_add(p, v, __ATOMIC_RELAXED, __HIP_MEMORY_SCOPE_AGENT); }
__device__ __forceinline__ unsigned xb_xcc_id() { return (unsigned)__builtin_amdgcn_s_getreg((3 << 11) | 20) & 0xFu; }
#define XB_SPIN(cond, bar) do { unsigned _sp = 0; while (cond) { __builtin_amdgcn_s_sleep(1); \
    if ((++_sp & 255u) == 0u) { if (xb_ld(&(bar)[XB_TMO])) break; if (_sp > XB_SPIN_CAP) { atomicAdd(&(bar)[XB_TMO], 1u); break; } } } } while (0)
struct XcdBarrier { unsigned* bar; unsigned x; volatile LAS unsigned* st; };
__device__ __forceinline__ XcdBarrier xcd_barrier_post(unsigned* bar, volatile LAS unsigned* st) {
    XcdBarrier b; b.bar = bar; b.x = xb_xcc_id(); b.st = st;
    if (threadIdx.x == 0) (void)xb_add(&bar[XB_XCNT(b.x)], 1u);
    return b;
}
__device__ __forceinline__ void xcd_barrier_complete(unsigned* bar, unsigned x, unsigned& nloc, unsigned& nx) {
    const unsigned G = gridDim.x * gridDim.y * gridDim.z;
    unsigned sum, cnt, mine, sp = 0u;
    for (;;) {
        sum = 0u; cnt = 0u; mine = 0u;
#pragma unroll
        for (unsigned j = 0; j < 16; ++j) { const unsigned c = xb_ld(&bar[XB_XCNT(j)]); sum += c; cnt += (c > 0u) ? 1u : 0u; mine = (j == x) ? c : mine; }
        if (sum == G) break;
        __builtin_amdgcn_s_sleep(1);
        if ((++sp & 255u) == 0u) { if (xb_ld(&bar[XB_TMO])) break; if (sp > XB_SPIN_CAP) { atomicAdd(&bar[XB_TMO], 1u); break; } }
    }
    nloc = mine > 0u ? mine : 1u; nx = cnt > 0u ? cnt : 1u;
}
__device__ __forceinline__ void xcd_barrier(const XcdBarrier& b) {
    asm volatile("s_waitcnt vmcnt(0)" ::: "memory");
    __syncthreads();
    if (threadIdx.x == 0) {
        unsigned* bar = b.bar;
        __builtin_amdgcn_s_waitcnt(0);
        unsigned nloc = b.st[0], nx = b.st[1];
        if (nloc == 0u) { xcd_barrier_complete(bar, b.x, nloc, nx); b.st[0] = nloc; b.st[1] = nx; }
        const unsigned old = xb_add(&bar[XB_XSUB(b.x)], 1u);
        const unsigned gen = old / nloc;
        if (old + 1u == (gen + 1u) * nloc) {
            __builtin_amdgcn_fence(__ATOMIC_RELEASE, "agent");
            asm volatile("s_waitcnt vmcnt(0)" ::: "memory");
            const unsigned og = xb_add(&bar[XB_TOP], 1u);
            const unsigned tg = og / nx;
            if (og + 1u == (tg + 1u) * nx) xb_add(&bar[XB_TOPGEN], 1u);
            else XB_SPIN(xb_ld(&bar[XB_TOPGEN]) == tg, bar);
            __builtin_amdgcn_fence(__ATOMIC_ACQUIRE, "agent");
            xb_add(&bar[XB_XGEN(b.x)], 1u);
            asm volatile("s_waitcnt vmcnt(0)" ::: "memory");
        } else {
            XB_SPIN(xb_ld(&bar[XB_XGEN(b.x)]) == gen, bar);
            __builtin_amdgcn_fence(__ATOMIC_ACQUIRE, "agent");
            asm volatile("s_waitcnt vmcnt(0)" ::: "memory");
        }
    }
    __syncthreads();
}

constexpr int BM = 256, BK = 64, HALF = 128, HTB = HALF * BK * 2, NXCD = 8, WGM = 8;
__host__ __device__ __forceinline__ int lds_byte(int r, int c) { const int st = (r >> 4) * 2 + (c >> 5), rr = r & 15, cc = c & 31, ob = rr * 64 + cc * 2; return st * 1024 + (ob ^ (((ob >> 9) & 1) << 5)); }
__host__ __device__ __forceinline__ void stage_rc(int b, int& R, int& C) { const int st = b / 1024, sb = b % 1024, swz = sb ^ (((sb >> 9) & 1) << 5); R = (st >> 1) * 16 + swz / 64; C = (st & 1) * 32 + (swz % 64) / 2; }
struct Unit { int pm, pn; };
struct StaticOrder {
    int nM, nN, nwg, G, c;
    __device__ void init(int M, int N, int G_, int c_) { nM = M / BM; nN = N / BM; nwg = nM * nN; G = G_; c = c_; }
    __device__ bool next(int i, Unit& u) const {
        const long L = (long)i * G + c; if (L >= nwg) return false;
        int wgid = (int)L; { const int q = nwg / NXCD, r = nwg % NXCD, xcd = wgid % NXCD, off = wgid / NXCD; wgid = (xcd < r ? xcd * (q + 1) : r * (q + 1) + (xcd - r) * q) + off; }
        const int nig = WGM * nN, gid = wgid / nig, fm = gid * WGM, gsz = (nM - fm) < WGM ? (nM - fm) : WGM;
        u.pm = fm + ((wgid % nig) % gsz); u.pn = (wgid % nig) / gsz; return true;
    }
};

template <class Epi>
__device__ __forceinline__ void gemm_phase(LAS unsigned char* lds, const bf16_t* gA, const bf16_t* gBt, int M, int N, int K, const Epi E) {
    int tid_ = threadIdx.x; asm volatile("" : "+v"(tid_));
    const int tid = tid_, wid = __builtin_amdgcn_readfirstlane(tid >> 6), lane = tid & 63, wr = wid >> 2, wc = wid & 3, fr = lane & 15, fq = lane >> 4;
    const int nt = K / BK;
    StaticOrder S; S.init(M, N, (int)gridDim.x, (int)blockIdx.x);
    unsigned voffA[2];
#pragma unroll
    for (int i = 0; i < 2; ++i) { int R, C; stage_rc(tid * 16 + i * 8192, R, C); voffA[i] = (unsigned)(R * K + C) * 2u; }
    const size_t kstep = (size_t)(BK * 2);
    const size_t hstep = (size_t)HALF * K * 2;
    const size_t tstep = 2 * hstep;
    const unsigned ldsw = (unsigned)wid * 1024u;
    const int aoff = lds_byte(wr * 64 + fr, fq * 8), boff = lds_byte(wc * 32 + fr, fq * 8);
#define PG8_SA(b, h) (((b) * 2 + (h)) * HTB)
#define PG8_SB(b, h) ((4 + (b) * 2 + (h)) * HTB)
#define PG8_STAGE(bufoff, gbase, voff) do { _Pragma("unroll") for (int _i = 0; _i < 2; ++_i) \
        __builtin_amdgcn_global_load_lds((const unsigned*)((const char*)(gbase) + (voff)[_i]), (LAS unsigned*)(lds + (bufoff) + ldsw + _i * 8192), 16, 0, 0); } while (0)
#define PG8_LDA(dst, b, h) do { _Pragma("unroll") for (int m = 0; m < 4; ++m) _Pragma("unroll") for (int k = 0; k < 2; ++k) dst[m][k] = *(const LAS bf16x8*)(lds + PG8_SA(b, h) + aoff + m * 2048 + k * 1024); } while (0)
#define PG8_LDB(dst, b, h) do { _Pragma("unroll") for (int n = 0; n < 2; ++n) _Pragma("unroll") for (int k = 0; k < 2; ++k) dst[n][k] = *(const LAS bf16x8*)(lds + PG8_SB(b, h) + boff + n * 2048 + k * 1024); } while (0)
#define PG8_MMA(ai, bj, At, Bt) do { __builtin_amdgcn_s_setprio(1); _Pragma("unroll") for (int m = 0; m < 4; ++m) _Pragma("unroll") for (int n = 0; n < 2; ++n) _Pragma("unroll") for (int k = 0; k < 2; ++k) \
        acc[ai][bj][m][n] = __builtin_amdgcn_mfma_f32_16x16x32_bf16(Bt[n][k], At[m][k], acc[ai][bj][m][n], 0, 0, 0); __builtin_amdgcn_s_setprio(0); } while (0)
#define PG8_WAIT_V(n) asm volatile("s_waitcnt vmcnt(" #n ")" ::: "memory")
#define PG8_WAIT_L(n) asm volatile("s_waitcnt lgkmcnt(" #n ")" ::: "memory")
#define PG8_BAR __builtin_amdgcn_s_barrier()
#define PG8_SCHED __builtin_amdgcn_sched_barrier(0)
    Unit cur, nxt; int ui = 0;
    if (!S.next(0, cur)) return;
    f32x4 acc[2][2][4][2];
#pragma unroll
    for (int a = 0; a < 2; ++a)
#pragma unroll
        for (int b = 0; b < 2; ++b)
#pragma unroll
            for (int m = 0; m < 4; ++m)
#pragma unroll
                for (int n = 0; n < 2; ++n) acc[a][b][m][n] = zero4();
    bf16x8 At[4][2], B0[2][2], B1[2][2];
    const char* cA = (const char*)gA + (size_t)cur.pm * tstep; const char* cB = (const char*)gBt + (size_t)cur.pn * tstep;
    PG8_STAGE(PG8_SB(0, 0), cB, voffA); PG8_STAGE(PG8_SA(0, 0), cA, voffA); PG8_STAGE(PG8_SB(0, 1), cB + hstep, voffA); PG8_STAGE(PG8_SA(0, 1), cA + hstep, voffA);
    if (wr == 1) PG8_BAR;
    PG8_WAIT_V(4); PG8_BAR;
    PG8_STAGE(PG8_SB(1, 0), cB + kstep, voffA); PG8_STAGE(PG8_SA(1, 0), cA + kstep, voffA); PG8_STAGE(PG8_SB(1, 1), cB + hstep + kstep, voffA);
    PG8_WAIT_V(6); PG8_BAR;
    for (;;) {
        const bool has_next = S.next(ui + 1, nxt);
        const char* nA = has_next ? (const char*)gA + (size_t)nxt.pm * tstep : cA; const char* nB = has_next ? (const char*)gBt + (size_t)nxt.pn * tstep : cB;
        for (int t = 0; t < nt; t += 2) {
            const bool last = (t == nt - 2);
            const char* a1 = cA + (size_t)(t + 1) * kstep;
            const char* a2 = last ? nA : cA + (size_t)(t + 2) * kstep; const char* b2 = last ? nB : cB + (size_t)(t + 2) * kstep;
            const char* a3 = a2 + kstep; const char* b3 = b2 + kstep;
            PG8_LDB(B0, 0, 0); PG8_SCHED; PG8_LDA(At, 0, 0); PG8_STAGE(PG8_SA(1, 1), a1 + hstep, voffA);
            PG8_WAIT_L(8); PG8_BAR; PG8_WAIT_L(0); PG8_MMA(0, 0, At, B0); PG8_BAR; PG8_SCHED;
            PG8_LDB(B1, 0, 1); PG8_STAGE(PG8_SB(0, 0), b2, voffA);
            PG8_BAR; PG8_WAIT_L(0); PG8_MMA(0, 1, At, B1); PG8_BAR;
            PG8_LDA(At, 0, 1); PG8_STAGE(PG8_SA(0, 0), a2, voffA);
            PG8_BAR; PG8_WAIT_L(0); PG8_MMA(1, 0, At, B0); PG8_BAR; PG8_SCHED;
            PG8_STAGE(PG8_SB(0, 1), b2 + hstep, voffA);
            PG8_WAIT_V(6); PG8_BAR; PG8_MMA(1, 1, At, B1); PG8_BAR;
            PG8_LDB(B0, 1, 0); PG8_SCHED; PG8_LDA(At, 1, 0); PG8_STAGE(PG8_SA(0, 1), a2 + hstep, voffA);
            PG8_WAIT_L(8); PG8_BAR; PG8_WAIT_L(0); PG8_MMA(0, 0, At, B0); PG8_BAR; PG8_SCHED;
            PG8_LDB(B1, 1, 1); PG8_STAGE(PG8_SB(1, 0), b3, voffA);
            PG8_BAR; PG8_WAIT_L(0); PG8_MMA(0, 1, At, B1); PG8_BAR;
            PG8_LDA(At, 1, 1); PG8_STAGE(PG8_SA(1, 0), a3, voffA);
            PG8_BAR; PG8_WAIT_L(0); PG8_MMA(1, 0, At, B0); PG8_BAR; PG8_SCHED;
            PG8_STAGE(PG8_SB(1, 1), b3 + hstep, voffA);
            PG8_WAIT_V(6); PG8_BAR; PG8_MMA(1, 1, At, B1); PG8_BAR;
        }
        E(acc, cur, wr, wc, fr, fq);
        if (!has_next) break;
#pragma unroll
        for (int a = 0; a < 2; ++a)
#pragma unroll
            for (int b = 0; b < 2; ++b)
#pragma unroll
                for (int m = 0; m < 4; ++m)
#pragma unroll
                    for (int n = 0; n < 2; ++n) acc[a][b][m][n] = zero4();
        cur = nxt; cA = nA; cB = nB; ++ui;
    }
    PG8_WAIT_V(0);
    if (wr == 0) PG8_BAR;
    PG8_BAR;
#undef PG8_SA
#undef PG8_SB
#undef PG8_STAGE
#undef PG8_LDA
#undef PG8_LDB
#undef PG8_MMA
#undef PG8_WAIT_V
#undef PG8_WAIT_L
#undef PG8_BAR
#undef PG8_SCHED
}

struct EpiIn {
    unsigned char* ws;
    __device__ __forceinline__ void operator()(const f32x4 (&acc)[2][2][4][2], const Unit& u, int wr, int wc, int fr, int fq) const {
        bf16_t* const U = (bf16_t*)(ws + OFF_U); bf16_t* const Z = (bf16_t*)(ws + OFF_Z); bf16_t* const Q = (bf16_t*)(ws + OFF_Q); bf16_t* const Kp = (bf16_t*)(ws + OFF_K);
        bf16_t* const V = (bf16_t*)(ws + OFF_V); bf16_t* const OG = (bf16_t*)(ws + OFF_OG); float* const G = (float*)(ws + OFF_G);
        const int row0 = u.pm * BM + wr * 64 + fr, pn = u.pn, lc0 = wc * 32 + 8 * fq;
        if (pn < 8 || (pn >= 24 && pn < 32)) {
            const bool glu = pn < 8;
            bf16_t* dst = glu ? U : OG; const int colb = (glu ? pn : pn - 24) * 128 + lc0;
#pragma unroll
            for (int ai = 0; ai < 2; ++ai)
#pragma unroll
                for (int m = 0; m < 4; ++m) {
                    const size_t r = (size_t)(row0 + ai * HALF + m * 16);
                    float o[8];
#pragma unroll
                    for (int n = 0; n < 2; ++n)
#pragma unroll
                        for (int j = 0; j < 4; ++j) {
                            const float a = acc[ai][0][m][n][j], g = acc[ai][1][m][n][j];
                            o[n * 4 + j] = glu ? a * sigmoidf_(g) : sigmoidf_(a) * siluf_(g);
                        }
                    u32x4 w; w.x = cvt_pk_bf16(o[0], o[1]); w.y = cvt_pk_bf16(o[2], o[3]); w.z = cvt_pk_bf16(o[4], o[5]); w.w = cvt_pk_bf16(o[6], o[7]);
                    *(u32x4*)(dst + r * 1024 + colb) = w;
                }
        } else if (pn < 24) {
            const int t = (pn - 8) >> 2;
            bf16_t* dst = t == 0 ? Z : (t == 1 ? Q : (t == 2 ? Kp : V));
            const int colb = ((pn - 8) & 3) * 256 + wc * 64 + 8 * fq;
            const float qs = 0.08838834764831845f;
#pragma unroll
            for (int ai = 0; ai < 2; ++ai)
#pragma unroll
                for (int m = 0; m < 4; ++m) {
                    const size_t r = (size_t)(row0 + ai * HALF + m * 16);
#pragma unroll
                    for (int bj = 0; bj < 2; ++bj) {
                        float o[8];
#pragma unroll
                        for (int n = 0; n < 2; ++n)
#pragma unroll
                            for (int j = 0; j < 4; ++j) {
                                const float a = acc[ai][bj][m][n][j];
                                o[n * 4 + j] = t == 0 ? siluf_(a) : (t == 1 ? a * qs : a);
                            }
                        u32x4 w; w.x = cvt_pk_bf16(o[0], o[1]); w.y = cvt_pk_bf16(o[2], o[3]); w.z = cvt_pk_bf16(o[4], o[5]); w.w = cvt_pk_bf16(o[6], o[7]);
                        *(u32x4*)(dst + r * 1024 + colb + bj * 32) = w;
                    }
                }
        } else {
            if (wc == 0) {
#pragma unroll
                for (int ai = 0; ai < 2; ++ai)
#pragma unroll
                    for (int m = 0; m < 4; ++m) {
                        const size_t r = (size_t)(row0 + ai * HALF + m * 16);
#pragma unroll
                        for (int n = 0; n < 2; ++n)
#pragma unroll
                            for (int j = 0; j < 4; ++j) G[(size_t)(16 * n + 4 * fq + j) * MTOT + r] = acc[ai][0][m][n][j];
                    }
            }
        }
    }
};
struct EpiPw {
    unsigned char* ws;
    __device__ __forceinline__ void operator()(const f32x4 (&acc)[2][2][4][2], const Unit& u, int wr, int wc, int fr, int fq) const {
        const bf16_t* __restrict__ const Z = (const bf16_t*)(ws + OFF_Z); bf16_t* __restrict__ const CAT = (bf16_t*)(ws + OFF_CAT);
        const int row0 = u.pm * BM + wr * 64 + fr, colb = u.pn * BM + wc * 64 + 8 * fq;
#pragma unroll
        for (int ai = 0; ai < 2; ++ai) {
            u32x4 zz[4][2];
#pragma unroll
            for (int m = 0; m < 4; ++m)
#pragma unroll
                for (int bj = 0; bj < 2; ++bj) zz[m][bj] = *(const u32x4*)(Z + (size_t)(row0 + ai * HALF + m * 16) * 1024 + colb + bj * 32);
#pragma unroll
            for (int m = 0; m < 4; ++m) {
                const size_t r = (size_t)(row0 + ai * HALF + m * 16);
#pragma unroll
                for (int bj = 0; bj < 2; ++bj) {
                    const u32x4 z = zz[m][bj];
                    const f32x4 v0 = acc[ai][bj][m][0], v1 = acc[ai][bj][m][1];
                    u32x4 w;
                    w.x = cvt_pk_bf16(v0[0] * bflo(z.x), v0[1] * bfhi(z.x)); w.y = cvt_pk_bf16(v0[2] * bflo(z.y), v0[3] * bfhi(z.y));
                    w.z = cvt_pk_bf16(v1[0] * bflo(z.z), v1[1] * bfhi(z.z)); w.w = cvt_pk_bf16(v1[2] * bflo(z.w), v1[3] * bfhi(z.w));
                    *(u32x4*)(CAT + r * 2048 + colb + bj * 32) = w;
                }
            }
        }
    }
};
struct EpiOut {
    unsigned char* ws;
    __device__ __forceinline__ void operator()(const f32x4 (&acc)[2][2][4][2], const Unit& u, int wr, int wc, int fr, int fq) const {
        bf16_t* const O = (bf16_t*)(ws + OFF_OUT);
        const int row0 = u.pm * BM + wr * 64 + fr, colb = u.pn * BM + wc * 64 + 8 * fq;
#pragma unroll
        for (int ai = 0; ai < 2; ++ai)
#pragma unroll
            for (int m = 0; m < 4; ++m) {
                const size_t r = (size_t)(row0 + ai * HALF + m * 16);
#pragma unroll
                for (int bj = 0; bj < 2; ++bj) {
                    const f32x4 v0 = acc[ai][bj][m][0], v1 = acc[ai][bj][m][1];
                    u32x4 w; w.x = cvt_pk_bf16(v0[0], v0[1]); w.y = cvt_pk_bf16(v0[2], v0[3]); w.z = cvt_pk_bf16(v1[0], v1[1]); w.w = cvt_pk_bf16(v1[2], v1[3]);
                    *(u32x4*)(O + r * 2048 + colb + bj * 32) = w;
                }
            }
    }
};

__device__ __forceinline__ void side_work(const Params& p, LAS unsigned char* lds, int tasks, int l_ada, int l_w, int sid, int nside) {
    int tid_ = threadIdx.x; asm volatile("" : "+v"(tid_));
    const int tid = tid_, wid = tid >> 6, lane = tid & 63;
    LAS float* s5 = (LAS float*)lds;
    LAS float* red = (LAS float*)(lds + 40960);
    __syncthreads();
    if (tasks & 1) {
        for (int i = tid; i < 5 * 2048; i += 512) { const int r = i >> 11, k = i & 2047; const float v = r < 4 ? p.c[r * 2048 + k] : p.c_ctx[k]; s5[i] = siluf_(v); }
        __syncthreads();
        float* ADA = (float*)(p.ws + OFF_ADA);
        const int l = l_ada;
        for (int item = sid; item < 192; item += nside) {
            const int cq = lane & 7, kq = lane >> 3, col0 = item * 32;
            const float* w = p.w_ada + (size_t)l * 2048 * 6144 + col0 + cq * 4;
            f32x4 a0 = zero4(), a1 = a0, a2 = a0, a3 = a0, a4 = a0;
            const int k0 = wid * 256 + kq;
#pragma unroll 1
            for (int ib = 0; ib < 32; ib += 4) {
                f32x4 wv[4];
#pragma unroll
                for (int i = 0; i < 4; ++i) wv[i] = __builtin_nontemporal_load((const f32x4*)(w + (size_t)(k0 + 8 * (ib + i)) * 6144));
#pragma unroll
                for (int i = 0; i < 4; ++i) { const int k = k0 + 8 * (ib + i);
                    a0 += wv[i] * s5[k]; a1 += wv[i] * s5[2048 + k]; a2 += wv[i] * s5[4096 + k]; a3 += wv[i] * s5[6144 + k]; a4 += wv[i] * s5[8192 + k]; }
            }
#pragma unroll
            for (int j = 0; j < 4; ++j) {
#pragma unroll
                for (int o = 8; o < 64; o <<= 1) { a0[j] += bperm(a0[j], lane ^ o); a1[j] += bperm(a1[j], lane ^ o); a2[j] += bperm(a2[j], lane ^ o); a3[j] += bperm(a3[j], lane ^ o); a4[j] += bperm(a4[j], lane ^ o); }
            }
            if (lane < 8) {
                *(LAS f32x4*)(red + (wid * 5 + 0) * 32 + cq * 4) = a0; *(LAS f32x4*)(red + (wid * 5 + 1) * 32 + cq * 4) = a1; *(LAS f32x4*)(red + (wid * 5 + 2) * 32 + cq * 4) = a2;
                *(LAS f32x4*)(red + (wid * 5 + 3) * 32 + cq * 4) = a3; *(LAS f32x4*)(red + (wid * 5 + 4) * 32 + cq * 4) = a4;
            }
            __syncthreads();
            if (tid < 160) {
                const int r = tid >> 5, cl = tid & 31, cc = col0 + cl; float s = p.b_ada[l * 6144 + cc];
#pragma unroll
                for (int w8 = 0; w8 < 8; ++w8) s += red[(w8 * 5 + r) * 32 + cl];
                ADA[(size_t)(l * 5 + r) * 6144 + cc] = s;
            }
            __syncthreads();
        }
    }
    constexpr int NT_IN = (NINP / 64) * 32, NT_OUT = 32 * 32, NT_PW = 16 * 16;
    if (tasks & 6) {
        const int t_lo = (tasks & 2) ? 0 : NT_IN, t_hi = (tasks & 4) ? NT_IN + NT_OUT + NT_PW : NT_IN;
        const int l = l_w;
        for (int t = t_lo + sid * 8 + wid; t < t_hi; t += nside * 8) {
            const float* src; bf16_t* dst; int NS, K, nb, kb, kind;
            if (t < NT_IN) { kb = t / 132; nb = t % 132; src = p.w_in + (size_t)l * 2048 * NIN; NS = NIN; K = 2048; dst = (bf16_t*)(p.ws + OFF_WIN) + (size_t)l * NINP * 2048; kind = 0; }
            else if (t < NT_IN + NT_OUT) { const int t2 = t - NT_IN; kb = t2 / 32; nb = t2 % 32; src = p.w_out + (size_t)l * 2048 * 2048; NS = 2048; K = 2048; dst = (bf16_t*)(p.ws + OFF_WOUT) + (size_t)l * 2048 * 2048; kind = 1; }
            else { const int t3 = t - NT_IN - NT_OUT; kb = t3 / 16; nb = t3 % 16; src = p.w_pw2 + (size_t)l * 1024 * 1024; NS = 1024; K = 1024; dst = (bf16_t*)(p.ws + OFF_WPW) + (size_t)l * 1024 * 1024; kind = 2; }
            const int np = nb * 64 + lane;
            const int col = kind == 0 ? colmap_in(np) : (np & ~255) + ((np >> 5) & 3) * 64 + ((np >> 7) & 1) * 32 + perm32(np & 31);
            const float* sp = src + (size_t)(kb * 64) * NS + (col >= 0 ? col : 0);
            float v[64];
#pragma unroll
            for (int i = 0; i < 64; ++i) v[i] = __builtin_nontemporal_load(sp + (size_t)i * NS);
            if (col < 0) {
#pragma unroll
                for (int i = 0; i < 64; ++i) v[i] = 0.f;
            }
            LAS unsigned char* tw = lds + 51200 + wid * 9216;
#pragma unroll
            for (int j = 0; j < 8; ++j) {
                u32x4 w; w.x = cvt_pk_bf16(v[8 * j], v[8 * j + 1]); w.y = cvt_pk_bf16(v[8 * j + 2], v[8 * j + 3]); w.z = cvt_pk_bf16(v[8 * j + 4], v[8 * j + 5]); w.w = cvt_pk_bf16(v[8 * j + 6], v[8 * j + 7]);
                *(LAS u32x4*)(tw + lane * 144 + j * 16) = w;
            }
            bf16_t* dp = dst + (size_t)(nb * 64) * K + kb * 64;
#pragma unroll
            for (int s = 0; s < 8; ++s) {
                const int rr = s * 8 + (lane >> 3), ch = lane & 7;
                const u32x4 w = *(const LAS u32x4*)(tw + rr * 144 + ch * 16);
                *(u32x4*)(dp + (size_t)rr * K + ch * 8) = w;
            }
        }
    }
    __syncthreads();
}

__device__ __forceinline__ void phase_norm(const Params& p, int lpost, int lpre, bool alt = false) {
    int tid_ = threadIdx.x; asm volatile("" : "+v"(tid_));
    const int lane = tid_ & 63, gw = blockIdx.x * 8 + (tid_ >> 6), nw = gridDim.x * 8;
    const float* ADA = (const float*)(p.ws + OFF_ADA);
    const bf16_t* OUTB = (const bf16_t*)(p.ws + OFF_OUT); const bf16_t* XW = (const bf16_t*)(p.ws + OFF_XW);
    bf16_t* HX = (bf16_t*)(p.ws + (alt ? OFF_U : OFF_HX)); bf16_t* XWo = (bf16_t*)(p.ws + (alt ? OFF_HF : OFF_XW));
    const int nrows = lpre < 0 ? MLAT : MTOT;
    for (int row = gw; row < nrows; row += nw) {
        const int bi = row < MLAT ? (row >> 11) : 4;
        float xv[32];
        if (lpost <= 0) {
            const float* xs = row < MLAT ? p.x + (size_t)row * 2048 : p.ctx + (size_t)(row - MLAT) * 2048;
#pragma unroll
            for (int i = 0; i < 4; ++i) { const f32x4 a = *(const f32x4*)(xs + (i * 64 + lane) * 8), b = *(const f32x4*)(xs + (i * 64 + lane) * 8 + 4);
#pragma unroll
                for (int j = 0; j < 4; ++j) { xv[i * 8 + j] = a[j]; xv[i * 8 + 4 + j] = b[j]; } }
        } else {
#pragma unroll
            for (int i = 0; i < 4; ++i) { const u32x4 a = *(const u32x4*)(XW + (size_t)row * 2048 + (i * 64 + lane) * 8);
                xv[i * 8 + 0] = bflo(a.x); xv[i * 8 + 1] = bfhi(a.x); xv[i * 8 + 2] = bflo(a.y); xv[i * 8 + 3] = bfhi(a.y); xv[i * 8 + 4] = bflo(a.z); xv[i * 8 + 5] = bfhi(a.z); xv[i * 8 + 6] = bflo(a.w); xv[i * 8 + 7] = bfhi(a.w); }
        }
        if (lpost >= 0) {
            float o[32]; float ss = 0.f;
#pragma unroll
            for (int i = 0; i < 4; ++i) { const u32x4 a = *(const u32x4*)(OUTB + (size_t)row * 2048 + (i * 64 + lane) * 8);
                o[i * 8 + 0] = bflo(a.x); o[i * 8 + 1] = bfhi(a.x); o[i * 8 + 2] = bflo(a.y); o[i * 8 + 3] = bfhi(a.y); o[i * 8 + 4] = bflo(a.z); o[i * 8 + 5] = bfhi(a.z); o[i * 8 + 6] = bflo(a.w); o[i * 8 + 7] = bfhi(a.w); }
#pragma unroll
            for (int i = 0; i < 32; ++i) ss += o[i] * o[i];
            ss = wave_sum(ss, lane); const float rinv = rsqrtf(ss * (1.0f / 2048.0f) + EPS);
            const float* gt = ADA + (size_t)(lpost * 5 + bi) * 6144 + 4096; const float* gp = p.g_post + lpost * 2048;
#pragma unroll
            for (int i = 0; i < 4; ++i) { const int c = (i * 64 + lane) * 8;
                const f32x4 g0 = *(const f32x4*)(gt + c), g1 = *(const f32x4*)(gt + c + 4), p0 = *(const f32x4*)(gp + c), p1 = *(const f32x4*)(gp + c + 4);
#pragma unroll
                for (int j = 0; j < 4; ++j) { xv[i * 8 + j] += g0[j] * (o[i * 8 + j] * rinv * p0[j]); xv[i * 8 + 4 + j] += g1[j] * (o[i * 8 + 4 + j] * rinv * p1[j]); } }
            if (lpre < 0) {
#pragma unroll
                for (int i = 0; i < 4; ++i) { float* op = p.out + (size_t)row * 2048 + (i * 64 + lane) * 8;
                    *(f32x4*)op = (f32x4){xv[i * 8], xv[i * 8 + 1], xv[i * 8 + 2], xv[i * 8 + 3]}; *(f32x4*)(op + 4) = (f32x4){xv[i * 8 + 4], xv[i * 8 + 5], xv[i * 8 + 6], xv[i * 8 + 7]}; }
                continue;
            }
#pragma unroll
            for (int i = 0; i < 4; ++i) { u32x4 w; w.x = cvt_pk_bf16(xv[i * 8], xv[i * 8 + 1]); w.y = cvt_pk_bf16(xv[i * 8 + 2], xv[i * 8 + 3]); w.z = cvt_pk_bf16(xv[i * 8 + 4], xv[i * 8 + 5]); w.w = cvt_pk_bf16(xv[i * 8 + 6], xv[i * 8 + 7]);
                *(u32x4*)(XWo + (size_t)row * 2048 + (i * 64 + lane) * 8) = w; }
        }
        float ss = 0.f;
#pragma unroll
        for (int i = 0; i < 32; ++i) ss += xv[i] * xv[i];
        ss = wave_sum(ss, lane); const float rinv = rsqrtf(ss * (1.0f / 2048.0f) + EPS);
        const float* sh = ADA + (size_t)(lpre * 5 + bi) * 6144; const float* sc = sh + 2048; const float* g = p.g_pre + lpre * 2048;
#pragma unroll
        for (int i = 0; i < 4; ++i) {
            const int c = (i * 64 + lane) * 8; float hv[8];
#pragma unroll
            for (int hh = 0; hh < 2; ++hh) { const f32x4 s4 = *(const f32x4*)(sh + c + hh * 4), c4 = *(const f32x4*)(sc + c + hh * 4), g4 = *(const f32x4*)(g + c + hh * 4);
#pragma unroll
                for (int j = 0; j < 4; ++j) hv[hh * 4 + j] = xv[i * 8 + hh * 4 + j] * rinv * g4[j] * (c4[j] + 1.0f) + s4[j]; }
            u32x4 w; w.x = cvt_pk_bf16(hv[0], hv[1]); w.y = cvt_pk_bf16(hv[2], hv[3]); w.z = cvt_pk_bf16(hv[4], hv[5]); w.w = cvt_pk_bf16(hv[6], hv[7]);
            *(u32x4*)(HX + (size_t)row * 2048 + c) = w;
        }
    }
}

constexpr int SC_QS = 0, SC_KS = 17408, SC_VT = 34816, SC_VW = 41984, SC_SET = 49152  , SC_P = 98304, SC_CT = 107520, SC_GA = 120576, SC_SC = 157440;
constexpr int QSTR = 272, TSTR = 144, VSTR = 112, NPOS = 2304;
typedef short v4s __attribute__((ext_vector_type(4)));
__device__ __forceinline__ bf16x8 tr_read8(LAS unsigned char* base, int S, int c, int ks, int lane) {
    const int g = lane >> 4, q = (lane >> 2) & 3, pp = lane & 3;
    LAS unsigned char* a0 = base + (32 * ks + 8 * g + q) * S + 32 * c + 8 * pp;
    const v4s lo = __builtin_amdgcn_ds_read_tr16_b64_v4i16((LAS v4s*)a0);
    const v4s hi = __builtin_amdgcn_ds_read_tr16_b64_v4i16((LAS v4s*)(a0 + 4 * S));
    return (bf16x8){lo[0], lo[1], lo[2], lo[3], hi[0], hi[1], hi[2], hi[3]};
}
__device__ __forceinline__ void phase_scan(const Params& p, int l, LAS unsigned char* lds) {
    int tid_ = threadIdx.x; asm volatile("" : "+v"(tid_));
    const int tid = tid_, wid = tid >> 6, lane = tid & 63, fr = lane & 15, fq = lane >> 4;
    const bf16_t* Qg = (const bf16_t*)(p.ws + OFF_Q); const bf16_t* Kg = (const bf16_t*)(p.ws + OFF_K); const bf16_t* Vg = (const bf16_t*)(p.ws + OFF_V);
    const float* Gg = (const float*)(p.ws + OFF_G);
    LAS float* RB = (LAS float*)(lds + SC_GA); LAS float* CS = RB + NPOS; LAS float* EM = CS + NPOS; LAS float* WS = EM + NPOS;
    LAS float* BL = (LAS float*)(lds + SC_SC); LAS float* MG = BL + 36; LAS float* MST = MG + 36; LAS float* MNEW = MST + 36; LAS float* AA = MNEW + 36;
    const bool wr_ctx = l < DEPTH - 1;
    for (int item = blockIdx.x; item < 256; item += gridDim.x) {
        const int xcd = item & 7, idx = item >> 3, bh = xcd * 4 + (idx >> 3), sub = idx & 7, dir = sub >> 2, es = sub & 3, b = bh >> 3, h = bh & 7;
        const int flip = dir ? 63 : 0;
        bf16_t* Hg = (bf16_t*)(p.ws + (dir ? OFF_HB : OFF_HF));
        __syncthreads();
        {
            const float bi_ = p.b_gate[l * 32 + dir * 16 + h], bf_ = p.b_gate[l * 32 + dir * 16 + 8 + h];
            for (int j = wid; j < 36; j += 8) {
                int rb; if (j < 4) { const int oc = dir ? 3 - j : j; rb = MLAT + b * CTXL + oc * 64; } else { const int jl = j - 4, oc = dir ? 31 - jl : jl; rb = b * SEQL + oc * 64; }
                const int row = rb + (lane ^ flip);
                const float gi = Gg[(size_t)(dir * 16 + h) * MTOT + row] + bi_;
                const float gf = Gg[(size_t)(dir * 16 + 8 + h) * MTOT + row] + bf_;
                const float lf = fminf(gf, 0.f) - log1pf(__expf(-fabsf(gf)));
                float bs = lf;
#pragma unroll
                for (int o = 1; o < 64; o <<= 1) { const float t = bperm(bs, (lane - o) & 63); if (lane >= o) bs += t; }
                const float cs = gi - bs;
                float pm = cs;
#pragma unroll
                for (int o = 1; o < 64; o <<= 1) { const float t = bperm(pm, (lane - o) & 63); if (lane >= o) pm = fmaxf(pm, t); }
                const int pi = j * 64 + lane;
                RB[pi] = bs; CS[pi] = cs; EM[pi] = pm;
                const float bl = bperm(bs, 63), pml = bperm(pm, 63);
                if (lane == 0) { BL[j] = bl; MG[j] = bl + pml; }
            }
            __syncthreads();
            if (tid == 0) { float m = NEGV; for (int j = 0; j < 36; ++j) { MST[j] = m; const float mn = fmaxf(BL[j] + m, MG[j]); MNEW[j] = mn; AA[j] = __expf(BL[j] + m - mn); m = mn; } }
            __syncthreads();
            for (int pi = tid; pi < NPOS; pi += 512) {
                const int j = pi >> 6; const float B = RB[pi], pm = EM[pi], cs = CS[pi], mst = MST[j];
                const float mt = B + fmaxf(mst, pm);
                RB[pi] = B - mt; EM[pi] = __expf(-mt); WS[pi] = __expf(BL[j] + cs - MNEW[j]);
            }
            if (tid < 128) { const int s = tid >> 1, hf = tid & 1; unsigned z0 = 0u; asm volatile("" : "+v"(z0)); const u32x4 one = (u32x4){z0 + 0x3F80u, z0, z0, z0}, zz = (u32x4){z0, z0, z0, z0};
                *(LAS u32x4*)(lds + SC_VT + s * VSTR + 64 + hf * 16) = hf ? zz : one; *(LAS u32x4*)(lds + SC_VW + s * VSTR + 64 + hf * 16) = zz;
                *(LAS u32x4*)(lds + SC_SET + SC_VT + s * VSTR + 64 + hf * 16) = hf ? zz : one; *(LAS u32x4*)(lds + SC_SET + SC_VW + s * VSTR + 64 + hf * 16) = zz; }
            __syncthreads();
        }
        f32x4 st[3];
#pragma unroll
        for (int n = 0; n < 3; ++n) st[n] = zero4();
        u32x4 rqA[2], rkA[2], rvA, rqB[2], rkB[2], rvB;
        { unsigned z0 = 0u; asm volatile("" : "+v"(z0)); rvA = (u32x4){z0, z0, z0, z0}; rvB = rvA; }
#define SCAN_ROWBASE(j, rbv) do { if ((j) < 4) { const int oc_ = dir ? 3 - (j) : (j); rbv = MLAT + b * CTXL + oc_ * 64; } else { const int jl_ = (j) - 4, oc_ = dir ? 31 - jl_ : jl_; rbv = b * SEQL + oc_ * 64; } } while (0)
#define SCAN_LOAD(j, rq, rk, rv) do { int rb_; SCAN_ROWBASE(j, rb_); \
        _Pragma("unroll") for (int i = 0; i < 2; ++i) { const int ix = tid + i * 512; rq[i] = *(const u32x4*)(Qg + (size_t)(rb_ + (ix >> 4)) * 1024 + h * 128 + (ix & 15) * 8); \
                                                         rk[i] = *(const u32x4*)(Kg + (size_t)(rb_ + (ix >> 4)) * 1024 + h * 128 + (ix & 15) * 8); } \
        if (tid < 256) rv = *(const u32x4*)(Vg + (size_t)(rb_ + (tid >> 2)) * 1024 + h * 128 + es * 32 + (tid & 3) * 8); } while (0)
#define SCAN_WRITE(j, rq, rk, rv, WB) do { \
        _Pragma("unroll") for (int i = 0; i < 2; ++i) { const int ix = tid + i * 512; *(LAS u32x4*)(lds + (WB) + SC_QS + (ix >> 4) * QSTR + (ix & 15) * 16) = rq[i]; *(LAS u32x4*)(lds + (WB) + SC_KS + (ix >> 4) * QSTR + (ix & 15) * 16) = rk[i]; } \
        if (tid < 256) { const int s_ = tid >> 2; const float ws_ = WS[(j) * 64 + (s_ ^ flip)]; *(LAS u32x4*)(lds + (WB) + SC_VT + s_ * VSTR + (tid & 3) * 16) = rv; \
            u32x4 vw_; vw_.x = cvt_pk_bf16(bflo(rv.x) * ws_, bfhi(rv.x) * ws_); vw_.y = cvt_pk_bf16(bflo(rv.y) * ws_, bfhi(rv.y) * ws_); \
            vw_.z = cvt_pk_bf16(bflo(rv.z) * ws_, bfhi(rv.z) * ws_); vw_.w = cvt_pk_bf16(bflo(rv.w) * ws_, bfhi(rv.w) * ws_); *(LAS u32x4*)(lds + (WB) + SC_VW + s_ * VSTR + (tid & 3) * 16) = vw_; } \
        else if (tid < 320) { const float ws_ = WS[(j) * 64 + (lane ^ flip)]; unsigned z0 = 0u; asm volatile("" : "+v"(z0)); *(LAS u32x4*)(lds + (WB) + SC_VW + lane * VSTR + 64) = (u32x4){cvt_pk_bf16(ws_, 0.f), z0, z0, z0}; } } while (0)
#define SCAN_STEP(jv, LQ, LK, LV, WQ, WK, WV, RBASE, WBASE) do { const int j = (jv); \
            if (j + 2 < 36) SCAN_LOAD(j + 2, LQ, LK, LV); \
            const int g0 = j * 64; \
            const int mt_ = wid & 3, nr = wid >> 2; \
            bf16x8 qf[4]; \
            { \
                const int ms0 = (wid >> 2) * 2; \
                f32x4 sa[2]; sa[0] = zero4(); sa[1] = sa[0]; \
_Pragma("unroll") \
                for (int kk = 0; kk < 4; ++kk) { \
                    qf[kk] = *(const LAS bf16x8*)(lds + (RBASE) + SC_QS + (mt_ * 16 + fr) * QSTR + kk * 64 + fq * 16); \
_Pragma("unroll") \
                    for (int i = 0; i < 2; ++i) { const bf16x8 ak = *(const LAS bf16x8*)(lds + (RBASE) + SC_KS + ((ms0 + i) * 16 + fr) * QSTR + kk * 64 + fq * 16); sa[i] = __builtin_amdgcn_mfma_f32_16x16x32_bf16(ak, qf[kk], sa[i], 0, 0, 0); } \
                } \
                const int t = mt_ * 16 + fr, tp = t ^ flip; const float rbt = RB[g0 + tp]; \
_Pragma("unroll") \
                for (int i = 0; i < 2; ++i) { \
                    const int s0 = (ms0 + i) * 16 + fq * 4; float pv[4]; \
_Pragma("unroll") \
                    for (int jj = 0; jj < 4; ++jj) { const int sp = (s0 + jj) ^ flip; pv[jj] = (sp <= tp) ? sa[i][jj] * __expf(rbt + CS[g0 + sp]) : 0.f; } \
                    u32x2 w; w.x = cvt_pk_bf16(pv[0], pv[1]); w.y = cvt_pk_bf16(pv[2], pv[3]); \
                    *(LAS u32x2*)(lds + SC_P + t * TSTR + s0 * 2) = w; \
                } \
_Pragma("unroll") \
                for (int n = 0; n < 3; ++n) { u32x2 w; w.x = cvt_pk_bf16(st[n][0], st[n][1]); w.y = cvt_pk_bf16(st[n][2], st[n][3]); *(LAS u32x2*)(lds + SC_CT + (n * 16 + fr) * QSTR + (wid * 16 + fq * 4) * 2) = w; } \
            } \
            if (j + 1 < 36) { SCAN_WRITE(j + 1, WQ, WK, WV, WBASE); } \
            __syncthreads(); \
            { \
                f32x4 ar = zero4(), aa = ar; \
_Pragma("unroll") \
                for (int kk = 0; kk < 4; ++kk) { \
                    const bf16x8 br = *(const LAS bf16x8*)(lds + SC_CT + (nr * 16 + fr) * QSTR + kk * 64 + fq * 16); \
                    const bf16x8 ba = *(const LAS bf16x8*)(lds + SC_CT + (32 + fr) * QSTR + kk * 64 + fq * 16); \
                    ar = __builtin_amdgcn_mfma_f32_16x16x32_bf16(qf[kk], br, ar, 0, 0, 0); aa = __builtin_amdgcn_mfma_f32_16x16x32_bf16(qf[kk], ba, aa, 0, 0, 0); \
                } \
                const int t0 = mt_ * 16 + fq * 4; \
_Pragma("unroll") \
                for (int jj = 0; jj < 4; ++jj) { const float wi = __expf(RB[g0 + ((t0 + jj) ^ flip)] + MST[j]); ar[jj] *= wi; aa[jj] *= wi; } \
_Pragma("unroll") \
                for (int kk = 0; kk < 2; ++kk) { \
                    const bf16x8 ap = *(const LAS bf16x8*)(lds + SC_P + (mt_ * 16 + fr) * TSTR + kk * 64 + fq * 16); \
                    const bf16x8 br = tr_read8(lds + (RBASE) + SC_VT, VSTR, nr, kk, lane); \
                    const bf16x8 ba = tr_read8(lds + (RBASE) + SC_VT, VSTR, 2, kk, lane); \
                    ar = __builtin_amdgcn_mfma_f32_16x16x32_bf16(ap, br, ar, 0, 0, 0); aa = __builtin_amdgcn_mfma_f32_16x16x32_bf16(ap, ba, aa, 0, 0, 0); \
                } \
                int rb_; SCAN_ROWBASE(j, rb_); \
                const bool do_wr = (j >= 4) || wr_ctx; \
_Pragma("unroll") \
                for (int jj = 0; jj < 4; ++jj) { \
                    const float den = bperm(aa[jj], lane & 48); const float em = EM[g0 + ((t0 + jj) ^ flip)]; \
                    const float hv = ar[jj] / fmaxf(fabsf(den), em); \
                    const float hn = bperm(hv, lane ^ 1); \
                    if (do_wr && !(fr & 1)) *(unsigned*)(Hg + (size_t)(rb_ + t0 + jj) * 1024 + h * 128 + es * 32 + nr * 16 + fr) = cvt_pk_bf16(hv, hn); \
                } \
                const float aj = AA[j]; \
_Pragma("unroll") \
                for (int n = 0; n < 3; ++n) st[n] *= aj; \
_Pragma("unroll") \
                for (int kk = 0; kk < 2; ++kk) { \
                    const bf16x8 ak = tr_read8(lds + (RBASE) + SC_KS, QSTR, wid, kk, lane); \
_Pragma("unroll") \
                    for (int n = 0; n < 3; ++n) { const bf16x8 bv = tr_read8(lds + (RBASE) + SC_VW, VSTR, n, kk, lane); st[n] = __builtin_amdgcn_mfma_f32_16x16x32_bf16(ak, bv, st[n], 0, 0, 0); } \
                } \
            } \
            __syncthreads(); \
        } while (0)
        SCAN_LOAD(0, rqA, rkA, rvA);
        SCAN_WRITE(0, rqA, rkA, rvA, 0);
        __syncthreads();
        SCAN_LOAD(1, rqA, rkA, rvA);
        for (int j2 = 0; j2 < 36; j2 += 2) {
            SCAN_STEP(j2, rqB, rkB, rvB, rqA, rkA, rvA, 0, SC_SET);
            SCAN_STEP(j2 + 1, rqA, rkA, rvA, rqB, rkB, rvB, SC_SET, 0);
        }
#undef SCAN_STEP
#undef SCAN_ROWBASE
#undef SCAN_LOAD
#undef SCAN_WRITE
    }
}

__device__ __forceinline__ void phase_conv(const Params& p, int l, LAS unsigned char* lds) {
    int tid_ = threadIdx.x; asm volatile("" : "+v"(tid_));
    const int tid = tid_, lane = tid & 63, gw = blockIdx.x * 8 + (tid >> 6), nw = gridDim.x * 8;
    LAS float* wd = (LAS float*)lds;
    __syncthreads();
    for (int i = tid; i < 31 * 256; i += 512) *(LAS f32x4*)(wd + i * 4) = *(const f32x4*)(p.w_dw + (size_t)l * 31 * 1024 + i * 4);
    for (int i = tid; i < 256; i += 512) *(LAS f32x4*)(wd + 31 * 1024 + i * 4) = zero4();
    __syncthreads();
    const bf16_t* __restrict__ U = (const bf16_t*)(p.ws + OFF_U); bf16_t* __restrict__ UC = (bf16_t*)(p.ws + OFF_UC);
    const int cH = lane * 8, cV = 512 + lane * 8;
    const int nrows = l < DEPTH - 1 ? MTOT : MLAT;
    for (int row = gw; row < nrows; row += nw) {
        float acc[16];
        int zl = 0; asm volatile("" : "+v"(zl));
        { const f32x4 b0 = *(const f32x4*)(p.b_dw + l * 1024 + cH + zl), b1 = *(const f32x4*)(p.b_dw + l * 1024 + cH + 4 + zl), b2 = *(const f32x4*)(p.b_dw + l * 1024 + cV + zl), b3 = *(const f32x4*)(p.b_dw + l * 1024 + cV + 4 + zl);
#pragma unroll
          for (int i = 0; i < 4; ++i) { acc[i] = b0[i]; acc[4 + i] = b1[i]; acc[8 + i] = b2[i]; acc[12 + i] = b3[i]; } }
        const bool lat = row < MLAT;
        const int n = lat ? (row & 2047) : ((row - MLAT) & 255);
        const int posH = lat ? (n & 63) : n, limH = lat ? 64 : 256;
        const int posV = lat ? (n >> 6) : n, limV = lat ? 32 : 256, strV = lat ? 64 : 1;
#pragma unroll 1
        for (int jb = 0; jb < 32; jb += 8) {
            u32x4 uH[8], uV[8]; int wH[8], wV[8];
#pragma unroll
            for (int jj = 0; jj < 8; ++jj) {
                const int j = jb + jj, dj = j - 15;
                const bool okH = (j < 31) && ((unsigned)(posH + dj) < (unsigned)limH), okV = (j < 31) && ((unsigned)(posV + dj) < (unsigned)limV);
                const int rH = okH ? row + dj : row, rV = okV ? row + dj * strV : row;
                wH[jj] = (okH ? j : 31) * 1024; wV[jj] = (okV ? j : 31) * 1024;
                uH[jj] = *(const u32x4*)(U + (size_t)rH * 1024 + cH);
                uV[jj] = *(const u32x4*)(U + (size_t)rV * 1024 + cV);
            }
#pragma unroll
            for (int jj = 0; jj < 8; ++jj) {
                { const u32x4 uv = uH[jj]; const f32x4 w0 = *(const LAS f32x4*)(wd + wH[jj] + cH), w1 = *(const LAS f32x4*)(wd + wH[jj] + cH + 4);
                  acc[0] += bflo(uv.x) * w0[0]; acc[1] += bfhi(uv.x) * w0[1]; acc[2] += bflo(uv.y) * w0[2]; acc[3] += bfhi(uv.y) * w0[3];
                  acc[4] += bflo(uv.z) * w1[0]; acc[5] += bfhi(uv.z) * w1[1]; acc[6] += bflo(uv.w) * w1[2]; acc[7] += bfhi(uv.w) * w1[3]; }
                { const u32x4 uv = uV[jj]; const f32x4 w0 = *(const LAS f32x4*)(wd + wV[jj] + cV), w1 = *(const LAS f32x4*)(wd + wV[jj] + cV + 4);
                  acc[8] += bflo(uv.x) * w0[0]; acc[9] += bfhi(uv.x) * w0[1]; acc[10] += bflo(uv.y) * w0[2]; acc[11] += bfhi(uv.y) * w0[3];
                  acc[12] += bflo(uv.z) * w1[0]; acc[13] += bfhi(uv.z) * w1[1]; acc[14] += bflo(uv.w) * w1[2]; acc[15] += bfhi(uv.w) * w1[3]; }
            }
        }
        float s = 0.f;
#pragma unroll
        for (int i = 0; i < 16; ++i) s += acc[i];
        const float mean = wave_sum(s, lane) * (1.0f / 1024.0f);
        float q = 0.f;
#pragma unroll
        for (int i = 0; i < 16; ++i) { acc[i] -= mean; q += acc[i] * acc[i]; }
        const float rstd = rsqrtf(wave_sum(q, lane) * (1.0f / 1024.0f) + EPS);
        float y[16];
        asm volatile("" : "+v"(zl));
#pragma unroll
        for (int hh = 0; hh < 4; ++hh) {
            const int cb = (hh < 2 ? cH : cV) + (hh & 1) * 4;
            const f32x4 g4 = *(const f32x4*)(p.ln_g + l * 1024 + cb + zl), b4 = *(const f32x4*)(p.ln_b + l * 1024 + cb + zl);
#pragma unroll
            for (int i = 0; i < 4; ++i) y[hh * 4 + i] = siluf_(acc[hh * 4 + i] * rstd * g4[i] + b4[i]);
        }
        u32x4 w; w.x = cvt_pk_bf16(y[0], y[1]); w.y = cvt_pk_bf16(y[2], y[3]); w.z = cvt_pk_bf16(y[4], y[5]); w.w = cvt_pk_bf16(y[6], y[7]);
        *(u32x4*)(UC + (size_t)row * 1024 + cH) = w;
        w.x = cvt_pk_bf16(y[8], y[9]); w.y = cvt_pk_bf16(y[10], y[11]); w.z = cvt_pk_bf16(y[12], y[13]); w.w = cvt_pk_bf16(y[14], y[15]);
        *(u32x4*)(UC + (size_t)row * 1024 + cV) = w;
    }
}

__device__ __forceinline__ void phase_mout(const Params& p, int l, int sid, int nside) {
    int tid_ = threadIdx.x; asm volatile("" : "+v"(tid_));
    const int lane = tid_ & 63, gw = sid * 8 + (tid_ >> 6), nw = nside * 8;
    const bf16_t* HF = (const bf16_t*)(p.ws + OFF_HF); const bf16_t* HB = (const bf16_t*)(p.ws + OFF_HB);
    const bf16_t* OG = (const bf16_t*)(p.ws + OFF_OG); bf16_t* CAT = (bf16_t*)(p.ws + OFF_CAT);
    const int nrows = l < DEPTH - 1 ? MTOT : MLAT;
    const int c0 = lane * 16;
    for (int row = gw; row < nrows; row += nw) {
        float hv[16]; float s = 0.f;
#pragma unroll
        for (int i = 0; i < 2; ++i) {
            const u32x4 a = *(const u32x4*)(HF + (size_t)row * 1024 + c0 + i * 8), bb = *(const u32x4*)(HB + (size_t)row * 1024 + c0 + i * 8);
            hv[i * 8 + 0] = bflo(a.x) + bflo(bb.x); hv[i * 8 + 1] = bfhi(a.x) + bfhi(bb.x); hv[i * 8 + 2] = bflo(a.y) + bflo(bb.y); hv[i * 8 + 3] = bfhi(a.y) + bfhi(bb.y);
            hv[i * 8 + 4] = bflo(a.z) + bflo(bb.z); hv[i * 8 + 5] = bfhi(a.z) + bfhi(bb.z); hv[i * 8 + 6] = bflo(a.w) + bflo(bb.w); hv[i * 8 + 7] = bfhi(a.w) + bfhi(bb.w);
        }
#pragma unroll
        for (int i = 0; i < 16; ++i) s += hv[i];
        s += bperm(s, lane ^ 1); s += bperm(s, lane ^ 2); s += bperm(s, lane ^ 4);
        const float mean = s * (1.0f / 128.0f); float q = 0.f;
#pragma unroll
        for (int i = 0; i < 16; ++i) { hv[i] -= mean; q += hv[i] * hv[i]; }
        q += bperm(q, lane ^ 1); q += bperm(q, lane ^ 2); q += bperm(q, lane ^ 4);
        const float rstd = rsqrtf(q * (1.0f / 128.0f) + EPS);
        const u32x4 og0 = *(const u32x4*)(OG + (size_t)row * 1024 + c0), og1 = *(const u32x4*)(OG + (size_t)row * 1024 + c0 + 8);
        const unsigned ogw[8] = {og0.x, og0.y, og0.z, og0.w, og1.x, og1.y, og1.z, og1.w};
        unsigned ow[8];
#pragma unroll
        for (int i = 0; i < 8; ++i) {
            const float g0 = p.g_head[l * 1024 + c0 + 2 * i], g1 = p.g_head[l * 1024 + c0 + 2 * i + 1];
            ow[i] = cvt_pk_bf16(hv[2 * i] * rstd * g0 * bflo(ogw[i]), hv[2 * i + 1] * rstd * g1 * bfhi(ogw[i]));
        }
        *(u32x4*)(CAT + (size_t)row * 2048 + 1024 + c0) = (u32x4){ow[0], ow[1], ow[2], ow[3]};
        *(u32x4*)(CAT + (size_t)row * 2048 + 1024 + c0 + 8) = (u32x4){ow[4], ow[5], ow[6], ow[7]};
    }
}

__global__ void __launch_bounds__(512, 2) fwd_mega(const float* __restrict__ a0, const float* __restrict__ a1, const float* __restrict__ a2, const float* __restrict__ a3,
        const float* __restrict__ a4, const float* __restrict__ a5, const float* __restrict__ a6, const float* __restrict__ a7, const float* __restrict__ a8,
        const float* __restrict__ a9, const float* __restrict__ a10, const float* __restrict__ a11, const float* __restrict__ a12, const float* __restrict__ a13,
        const float* __restrict__ a14, const float* __restrict__ a15, const float* __restrict__ a16, float* outp, unsigned char* wsp, int ph_lo, int ph_hi, int pmode) {
    Params p; p.x = a0; p.c = a1; p.ctx = a2; p.c_ctx = a3; p.w_ada = a4; p.b_ada = a5; p.g_pre = a6; p.g_post = a7; p.w_in = a8; p.b_gate = a9; p.w_dw = a10; p.b_dw = a11;
    p.ln_g = a12; p.ln_b = a13; p.w_pw2 = a14; p.g_head = a15; p.w_out = a16; p.out = outp; p.ws = wsp; p.ph_lo = ph_lo; p.ph_hi = ph_hi;
    extern __shared__ __attribute__((aligned(16))) unsigned char shm[];
    LAS unsigned char* lds = (LAS unsigned char*)shm;
    cg::grid_group grid = cg::this_grid();
    volatile LAS unsigned* xst = (volatile LAS unsigned*)(lds + LDS_BYTES - 16);
    if (threadIdx.x == 0) { xst[0] = 0u; xst[1] = 0u; }
    __syncthreads();
    const XcdBarrier xbar = xcd_barrier_post((unsigned*)(wsp + OFF_BAR), xst);
    if (ph_hi > 1000) grid.sync();
#define GRID_SYNC() xcd_barrier(xbar)
    for (int ph = p.ph_lo; ph < p.ph_hi; ++ph) {
        size_t zoff = 0; asm volatile("" : "+s"(zoff)); unsigned char* ws = p.ws + zoff;
        const int G = (int)gridDim.x, bid = (int)blockIdx.x;
        int tasks = 0, l_ada = 0, l_w = 0, sid = bid, nside = G;
        if (ph == 0) { tasks = 1 | 2; }
        else if (ph == 1) phase_norm(p, -1, 0);
        else if (ph >= 100) { }
        else {
            const int l = (ph - 2) / 5, s = (ph - 2) % 5;
            if (s == 0) {
                EpiIn E; E.ws = ws;
                gemm_phase<EpiIn>(lds, (const bf16_t*)(ws + OFF_HX), (const bf16_t*)(ws + OFF_WIN) + (size_t)l * NINP * 2048, MTOT, NINP, 2048, E);
                const int nun = (MTOT / 256) * (NINP / 256), first_idle = nun % G;
                tasks = 4; l_w = l;
                if (first_idle != 0) { if (bid >= first_idle) { sid = bid - first_idle; nside = G - first_idle; } else tasks = 0; }
            } else if (s == 1) {
                if (pmode != 2) phase_scan(p, l, lds);
                if (pmode != 1) phase_conv(p, l, lds);
            } else if (s == 2) {
                const int Mr = l < DEPTH - 1 ? MTOT : MLAT;
                EpiPw E; E.ws = ws;
                gemm_phase<EpiPw>(lds, (const bf16_t*)(ws + OFF_UC), (const bf16_t*)(ws + OFF_WPW) + (size_t)l * 1024 * 1024, Mr, 1024, 1024, E);
                const int nun = (Mr / 256) * 4;
                if (nun < G) { if (bid >= nun) phase_mout(p, l, bid - nun, G - nun); } else phase_mout(p, l, bid, G);
            } else if (s == 3) {
                const int Mr = l < DEPTH - 1 ? MTOT : MLAT;
                EpiOut E; E.ws = ws;
                gemm_phase<EpiOut>(lds, (const bf16_t*)(ws + OFF_CAT), (const bf16_t*)(ws + OFF_WOUT) + (size_t)l * 2048 * 2048, Mr, 2048, 2048, E);
                if (l < DEPTH - 1) {
                    const int nun = (Mr / 256) * 8, first_idle = nun % G;
                    tasks = 2 | 1; l_w = l + 1; l_ada = l + 1;
                    if (first_idle != 0) { if (bid >= first_idle) { sid = bid - first_idle; nside = G - first_idle; } else tasks = 0; }
                }
            } else {
                phase_norm(p, l, l < DEPTH - 1 ? l + 1 : -1, p.ph_hi - p.ph_lo == 1);
            }
        }
        if (tasks) side_work(p, lds, tasks, l_ada, l_w, sid, nside);
        if (ph + 1 < p.ph_hi) GRID_SYNC();
    }
}

extern "C" void kernel_launch(void* const* d_in, const int* in_sizes, int n_in, void* d_out, int out_size, void* d_ws, size_t ws_size, hipStream_t stream) {
    static int grid_blocks = 0;
    if (grid_blocks == 0) {
        if (n_in != 17 || ws_size < WS_END) { fprintf(stderr, "kernel_launch: unexpected n_in %d or ws_size %zu (need %zu)\n", n_in, ws_size, (size_t)WS_END); grid_blocks = -1; return; }
        int dev = 0, cus = 0, per_cu = 0;
        (void)hipGetDevice(&dev);
        (void)hipDeviceGetAttribute(&cus, hipDeviceAttributeMultiprocessorCount, dev);
        if (hipFuncSetAttribute((const void*)fwd_mega, hipFuncAttributeMaxDynamicSharedMemorySize, LDS_BYTES) != hipSuccess) { fprintf(stderr, "kernel_launch: hipFuncSetAttribute failed\n"); grid_blocks = -1; return; }
        if (hipOccupancyMaxActiveBlocksPerMultiprocessor(&per_cu, (const void*)fwd_mega, 512, LDS_BYTES) != hipSuccess || per_cu < 1) { fprintf(stderr, "kernel_launch: occupancy query says %d\n", per_cu); per_cu = 1; (void)hipGetLastError(); }
        grid_blocks = cus * 1;
        if (grid_blocks <= 0) grid_blocks = 256;
    }
    if (grid_blocks < 0) return;
    Params p{};
    p.x = (const float*)d_in[0]; p.c = (const float*)d_in[1]; p.ctx = (const float*)d_in[2]; p.c_ctx = (const float*)d_in[3];
    p.w_ada = (const float*)d_in[4]; p.b_ada = (const float*)d_in[5]; p.g_pre = (const float*)d_in[6]; p.g_post = (const float*)d_in[7];
    p.w_in = (const float*)d_in[8]; p.b_gate = (const float*)d_in[9]; p.w_dw = (const float*)d_in[10]; p.b_dw = (const float*)d_in[11];
    p.ln_g = (const float*)d_in[12]; p.ln_b = (const float*)d_in[13]; p.w_pw2 = (const float*)d_in[14]; p.g_head = (const float*)d_in[15]; p.w_out = (const float*)d_in[16];
    p.out = (float*)d_out; p.ws = (unsigned char*)d_ws;
    p.ph_lo = 0; p.ph_hi = 2 + 5 * DEPTH;
    if (hipMemsetAsync((char*)d_ws + OFF_BAR, 0, 16384, stream) != hipSuccess) { fprintf(stderr, "kernel_launch: memset of barrier words failed\n"); return; }
    int pmode = 0;
    void* args[] = {&p.x, &p.c, &p.ctx, &p.c_ctx, &p.w_ada, &p.b_ada, &p.g_pre, &p.g_post, &p.w_in, &p.b_gate, &p.w_dw, &p.b_dw, &p.ln_g, &p.ln_b, &p.w_pw2, &p.g_head, &p.w_out, &p.out, &p.ws, &p.ph_lo, &p.ph_hi, &pmode};
    hipError_t e = hipLaunchCooperativeKernel((const void*)fwd_mega, dim3(grid_blocks), dim3(512), args, LDS_BYTES, stream);
    if (e != hipSuccess) fprintf(stderr, "cooperative launch failed: %s (grid %d)\n", hipGetErrorString(e), grid_blocks);
#if PROBE_PH >= 0
    for (int r = 0; r < PROBE_REPS; ++r) {
        p.ph_lo = PROBE_PH % 1000; p.ph_hi = p.ph_lo + 1; pmode = PROBE_PH / 1000;
        (void)hipMemsetAsync((char*)d_ws + OFF_BAR, 0, 16384, stream);
        (void)hipLaunchCooperativeKernel((const void*)fwd_mega, dim3(grid_blocks), dim3(512), args, LDS_BYTES, stream);
    }
#endif
}
```
